# Optimizing an MI355X kernel written in HIP

```python
import jax
import jax.numpy as jnp
from jax import lax
import numpy as np

D_MODEL = 1024
BATCH = 4
SEQ = 8192
DEPTH = 1

CTX_LEN = 256
GRID_W = 64
HEAD_DIM = 64
ATTN_Q_HEADS = 8
ATTN_KV_HEADS = 2
ATTN_GROUP = ATTN_Q_HEADS // ATTN_KV_HEADS
WINDOW = 128
BLOCK = 128
ROPE_BASE = 10000.0
ROPE_FREQS = HEAD_DIM // 4
GM_GROUPS = 8
GM_HEAD = 64
GM_CHUNK = 128
GM_WIDTH = GM_GROUPS * GM_HEAD
ATTN_WIDTH = ATTN_Q_HEADS * HEAD_DIM
KV_WIDTH = ATTN_KV_HEADS * HEAD_DIM
N_BRANCH = 2
Q0 = 0
K0 = Q0 + ATTN_WIDTH
V0 = K0 + KV_WIDTH
U0 = V0 + KV_WIDTH
VG0 = U0 + GM_WIDTH
GATE0 = VG0 + GM_WIDTH
IN_WIDTH = GATE0 + N_BRANCH * D_MODEL
N_GROUPS = 4
EXPERTS_PER_GROUP = 8
N_EXPERTS = N_GROUPS * EXPERTS_PER_GROUP
TOP_K_IN_GROUP = 2
D_EXPERT = D_MODEL // 2
EXPERT_BLOCK = 128
LN_EPS = 1e-6
NEG_INF = -1e30
ALPHA = (2.0 * DEPTH) ** 0.25
BETA = (8.0 * DEPTH) ** -0.25

kernel_name = 'hybrid_dit_window_gqa_gmlp_hmoe'


def _layernorm(x, g=None, b=None):
    xf = x.astype(jnp.float32)
    mu = jnp.mean(xf, -1, keepdims=True)
    var = jnp.mean(jnp.square(xf - mu), -1, keepdims=True)
    y = ((xf - mu) * lax.rsqrt(var + LN_EPS)).astype(x.dtype)
    if g is not None:
        y = y * g + b
    return y


def _modulate(h, shift, scale):
    return h * (1 + scale) + shift


def _rope_tables(pos, dtype):
    inv = 1.0 / (ROPE_BASE ** (jnp.arange(ROPE_FREQS, dtype=jnp.float32) / ROPE_FREQS))
    ang = pos.astype(jnp.float32)[:, None] * inv[None, :]
    return (jnp.cos(ang).astype(dtype)[:, None, :], jnp.sin(ang).astype(dtype)[:, None, :])


def _rotate(x, cos, sin):
    xa, xb = jnp.split(x, 2, axis=-1)
    return jnp.concatenate([xa * cos - xb * sin, xb * cos + xa * sin], -1)


def _rope_2d(x, rope):
    cos_r, sin_r, cos_c, sin_c = rope
    xr, xc = jnp.split(x, 2, axis=-1)
    return jnp.concatenate([_rotate(xr, cos_r, sin_r), _rotate(xc, cos_c, sin_c)], -1)


def _window_mask(n):
    nb = n // BLOCK
    blk = jnp.arange(nb, dtype=jnp.int32)[:, None, None]
    qpos = blk * BLOCK + jnp.arange(BLOCK, dtype=jnp.int32)[None, :, None]
    kpos = (blk - 1) * BLOCK + jnp.arange(3 * BLOCK, dtype=jnp.int32)[None, None, :]
    return (jnp.abs(qpos - kpos) <= WINDOW) & (kpos >= 0) & (kpos < n)


def _split_proj(p):
    b, n, _ = p.shape
    q = p[..., Q0:K0].reshape(b, n, ATTN_Q_HEADS, HEAD_DIM)
    k = p[..., K0:V0].reshape(b, n, ATTN_KV_HEADS, HEAD_DIM)
    v = p[..., V0:U0].reshape(b, n, ATTN_KV_HEADS, HEAD_DIM)
    u = p[..., U0:VG0]
    vg = p[..., VG0:GATE0]
    ga = p[..., GATE0:GATE0 + D_MODEL]
    gb = p[..., GATE0 + D_MODEL:IN_WIDTH]
    return q, k, v, u, vg, ga, gb


def _kv_proj(h, w_in):
    b, n, _ = h.shape
    kv = h @ w_in[:, K0:U0]
    k = kv[..., :KV_WIDTH].reshape(b, n, ATTN_KV_HEADS, HEAD_DIM)
    v = kv[..., KV_WIDTH:].reshape(b, n, ATTN_KV_HEADS, HEAD_DIM)
    return k, v


def _sink_column(sink, shape):
    s = sink.astype(jnp.float32).reshape(ATTN_KV_HEADS, ATTN_GROUP, 1, 1)
    return jnp.broadcast_to(s, shape[:-1] + (1,))


def _latent_attention(q, k, v, k_ctx, v_ctx, sink, mask):
    b, n = q.shape[:2]
    nb = n // BLOCK
    qb = q.reshape(b, nb, BLOCK, ATTN_KV_HEADS, ATTN_GROUP, HEAD_DIM)

    def band(t):
        tp = jnp.pad(t, ((0, 0), (BLOCK, BLOCK), (0, 0), (0, 0)))
        tp = tp.reshape(b, nb + 2, BLOCK, ATTN_KV_HEADS, HEAD_DIM)
        return jnp.concatenate([tp[:, :-2], tp[:, 1:-1], tp[:, 2:]], axis=2)

    kw, vw = band(k), band(v)
    s_loc = jnp.einsum('bnqhgd,bnkhd->bnhgqk', qb, kw).astype(jnp.float32)
    s_loc = jnp.where(mask[None, :, None, None], s_loc, NEG_INF)
    s_ctx = jnp.einsum('bnqhgd,bkhd->bnhgqk', qb, k_ctx).astype(jnp.float32)
    logits = jnp.concatenate([_sink_column(sink, s_ctx.shape), s_ctx, s_loc], -1)
    p = jax.nn.softmax(logits, -1).astype(q.dtype)
    c_len = k_ctx.shape[1]
    o = (jnp.einsum('bnhgqk,bkhd->bnqhgd', p[..., 1:1 + c_len], v_ctx)
         + jnp.einsum('bnhgqk,bnkhd->bnqhgd', p[..., 1 + c_len:], vw))
    return o.reshape(b, n, ATTN_WIDTH)


def _context_attention(q, k, v, sink):
    b, n = q.shape[:2]
    qg = q.reshape(b, n, ATTN_KV_HEADS, ATTN_GROUP, HEAD_DIM)
    s = jnp.einsum('bqhgd,bkhd->bhgqk', qg, k).astype(jnp.float32)
    p = jax.nn.softmax(jnp.concatenate([_sink_column(sink, s.shape), s], -1), -1)[..., 1:]
    o = jnp.einsum('bhgqk,bkhd->bqhgd', p.astype(q.dtype), v)
    return o.reshape(b, n, ATTN_WIDTH)


def _chunk_gmlp(u, v, lp):
    b, n, _ = u.shape
    u = jax.nn.gelu(u)
    v = _layernorm(jax.nn.gelu(v), lp['gm_ln_g'], lp['gm_ln_b'])
    vc = v.reshape(b, n // GM_CHUNK, GM_CHUNK, GM_GROUPS, GM_HEAD)
    sp = jnp.einsum('gpq,bnqgc->bnpgc', lp['gm_ws'], vc) + lp['gm_bs'].T[None, None, :, :, None]
    return u * sp.reshape(b, n, GM_WIDTH)


def _merge(y_attn, y_gm, ga, gb, lp):
    y = jax.nn.sigmoid(ga) * (y_attn @ lp['w_pa']) + jax.nn.sigmoid(gb) * (y_gm @ lp['w_pb'])
    return y @ lp['w_o']


def _hier_moe(h, lp):
    b, n, d = h.shape
    t = h.reshape(b * n, d)
    n_tok = b * n
    g_prob = jax.nn.softmax((t @ lp['router_g_w'] + lp['router_g_b']).astype(jnp.float32), -1)
    g_w, g_idx = lax.top_k(g_prob, 1)
    e_logit = (jnp.einsum('nd,gde->nge', t, lp['router_e_w']) + lp['router_e_b']).astype(jnp.float32)
    sel = jnp.broadcast_to(g_idx[:, :, None], (n_tok, 1, EXPERTS_PER_GROUP))
    e_logit = jnp.take_along_axis(e_logit, sel, axis=1)[:, 0]
    e_val, e_idx = lax.top_k(e_logit, TOP_K_IN_GROUP)
    e_w = jax.nn.softmax(e_val, -1)
    expert = g_idx * EXPERTS_PER_GROUP + e_idx
    weight = (g_w * e_w).astype(h.dtype)
    n_assign = n_tok * TOP_K_IN_GROUP
    e_flat = expert.reshape(-1)
    w_flat = weight.reshape(-1)
    tok_flat = jnp.repeat(jnp.arange(n_tok, dtype=jnp.int32), TOP_K_IN_GROUP)
    order = jnp.argsort(e_flat)
    e_sorted = e_flat[order]
    counts = jnp.bincount(e_flat, length=N_EXPERTS)
    padded = (counts + EXPERT_BLOCK - 1) // EXPERT_BLOCK * EXPERT_BLOCK
    pad_end = jnp.cumsum(padded)
    pad_start = pad_end - padded
    start = jnp.cumsum(counts) - counts
    pos = pad_start[e_sorted] + jnp.arange(n_assign, dtype=jnp.int32) - start[e_sorted]
    cap = -(-n_assign // EXPERT_BLOCK) * EXPERT_BLOCK + N_EXPERTS * EXPERT_BLOCK
    buf_tok = jnp.zeros((cap,), jnp.int32).at[pos].set(tok_flat[order])
    buf_w = jnp.zeros((cap,), h.dtype).at[pos].set(w_flat[order])
    n_blk = cap // EXPERT_BLOCK
    blk_e = jnp.searchsorted(pad_end, jnp.arange(n_blk, dtype=jnp.int32) * EXPERT_BLOCK, side='right')
    blk_e = jnp.minimum(blk_e, N_EXPERTS - 1)
    xb = t[buf_tok].reshape(n_blk, EXPERT_BLOCK, d)
    w1, w3, w2 = lp['moe_w1'], lp['moe_w3'], lp['moe_w2']

    def run_block(args):
        xt, e = args
        hid = jax.nn.silu(xt @ w1[e]) * (xt @ w3[e])
        return hid @ w2[e]

    y = lax.map(run_block, (xb, blk_e)).reshape(cap, d)
    out = jnp.zeros_like(t).at[buf_tok].add(y * buf_w[:, None])
    return out.reshape(b, n, d)


def setup_inputs(seed: int = 0) -> dict:
    key = jax.random.key(seed)
    ks = jax.random.split(key, 32)
    L, D = DEPTH, D_MODEL

    def nrm(k, shape, scale):
        return jax.random.normal(k, shape, jnp.float32) * scale

    return {
        'x': nrm(ks[0], (BATCH, SEQ, D), 1.0),
        'c': nrm(ks[1], (BATCH, D), 1.0),
        'ctx': nrm(ks[2], (BATCH, CTX_LEN, D), 1.0),
        'c_ctx': nrm(ks[3], (D,), 1.0),
        'w_ada': nrm(ks[4], (L, D, 6 * D), 0.5 * D ** -0.5),
        'b_ada': nrm(ks[5], (L, 6 * D), 0.02),
        'w_in': nrm(ks[6], (L, D, IN_WIDTH), D ** -0.5),
        'attn_sink': nrm(ks[7], (L, ATTN_Q_HEADS), 0.5),
        'gm_ln_g': 1.0 + nrm(ks[8], (L, GM_WIDTH), 0.02),
        'gm_ln_b': nrm(ks[9], (L, GM_WIDTH), 0.02),
        'gm_ws': nrm(ks[10], (L, GM_GROUPS, GM_CHUNK, GM_CHUNK), GM_CHUNK ** -0.5),
        'gm_bs': 1.0 + nrm(ks[11], (L, GM_GROUPS, GM_CHUNK), 0.02),
        'w_pa': nrm(ks[12], (L, ATTN_WIDTH, D), BETA * ATTN_WIDTH ** -0.5),
        'w_pb': nrm(ks[13], (L, GM_WIDTH, D), BETA * GM_WIDTH ** -0.5),
        'w_o': nrm(ks[14], (L, D, D), BETA * D ** -0.5),
        'ln1_g': 1.0 + nrm(ks[15], (L, D), 0.02),
        'ln1_b': nrm(ks[16], (L, D), 0.02),
        'router_g_w': nrm(ks[17], (L, D, N_GROUPS), D ** -0.5),
        'router_g_b': nrm(ks[18], (L, N_GROUPS), 0.01),
        'router_e_w': nrm(ks[19], (L, N_GROUPS, D, EXPERTS_PER_GROUP), D ** -0.5),
        'router_e_b': nrm(ks[20], (L, N_GROUPS, EXPERTS_PER_GROUP), 0.01),
        'moe_w1': nrm(ks[21], (L, N_EXPERTS, D, D_EXPERT), D ** -0.5),
        'moe_w3': nrm(ks[22], (L, N_EXPERTS, D, D_EXPERT), D ** -0.5),
        'moe_w2': nrm(ks[23], (L, N_EXPERTS, D_EXPERT, D), BETA * D_EXPERT ** -0.5),
        'ln2_g': 1.0 + nrm(ks[24], (L, D), 0.02),
        'ln2_b': nrm(ks[25], (L, D), 0.02),
    }


def reference(x, c, ctx, c_ctx, w_ada, b_ada, w_in, attn_sink, gm_ln_g, gm_ln_b, gm_ws, gm_bs,
              w_pa, w_pb, w_o, ln1_g, ln1_b, router_g_w, router_g_b, router_e_w, router_e_b,
              moe_w1, moe_w3, moe_w2, ln2_g, ln2_b):
    n_lat = x.shape[1]
    rows = n_lat // GRID_W
    row = jnp.repeat(jnp.arange(rows, dtype=jnp.int32), GRID_W)
    col = jnp.tile(jnp.arange(GRID_W, dtype=jnp.int32), rows)
    rope = _rope_tables(row, x.dtype) + _rope_tables(col, x.dtype)
    mask = _window_mask(n_lat)
    q_scale = HEAD_DIM ** -0.5
    for i in range(DEPTH):
        lp = {'gm_ln_g': gm_ln_g[i], 'gm_ln_b': gm_ln_b[i], 'gm_ws': gm_ws[i], 'gm_bs': gm_bs[i],
              'w_pa': w_pa[i], 'w_pb': w_pb[i], 'w_o': w_o[i],
              'router_g_w': router_g_w[i], 'router_g_b': router_g_b[i],
              'router_e_w': router_e_w[i], 'router_e_b': router_e_b[i],
              'moe_w1': moe_w1[i], 'moe_w3': moe_w3[i], 'moe_w2': moe_w2[i]}
        mod = jax.nn.silu(c) @ w_ada[i] + b_ada[i]
        sh1, sc1, g1, sh2, sc2, g2 = jnp.split(mod[:, None, :], 6, axis=-1)
        cmod = jax.nn.silu(c_ctx) @ w_ada[i] + b_ada[i]
        csh1, csc1, cg1, csh2, csc2, cg2 = jnp.split(cmod, 6, axis=-1)
        hc = _modulate(_layernorm(ctx), csh1, csc1)
        if i < DEPTH - 1:
            qc, k_ctx, v_ctx, uc, vgc, gac, gbc = _split_proj(hc @ w_in[i])
            mix_c = _merge(_context_attention(qc * q_scale, k_ctx, v_ctx, attn_sink[i]),
                           _chunk_gmlp(uc, vgc, lp), gac, gbc, lp)
            ctx = _layernorm(ALPHA * ctx + cg1 * mix_c, ln1_g[i], ln1_b[i])
            hc2 = _modulate(_layernorm(ctx), csh2, csc2)
            ctx = _layernorm(ALPHA * ctx + cg2 * _hier_moe(hc2, lp), ln2_g[i], ln2_b[i])
        else:
            k_ctx, v_ctx = _kv_proj(hc, w_in[i])
        h = _modulate(_layernorm(x), sh1, sc1)
        q, k, v, u, vg, ga, gb = _split_proj(h @ w_in[i])
        q = _rope_2d(q, rope) * q_scale
        k = _rope_2d(k, rope)
        y_attn = _latent_attention(q, k, v, k_ctx, v_ctx, attn_sink[i], mask)
        y_gm = _chunk_gmlp(u, vg, lp)
        mix = _merge(y_attn, y_gm, ga, gb, lp)
        x = _layernorm(ALPHA * x + g1 * mix, ln1_g[i], ln1_b[i])
        h2 = _modulate(_layernorm(x), sh2, sc2)
        x = _layernorm(ALPHA * x + g2 * _hier_moe(h2, lp), ln2_g[i], ln2_b[i])
    return x
```

```cpp
#include <hip/hip_runtime.h>
#include <cstdio>
#include <cstdint>

namespace nv {
constexpr int D = 1024, BATCH = 4, SEQ = 8192, CTX = 256, NTOK = BATCH * SEQ;
constexpr int INW = 3840, Q0 = 0, K0 = 512, V0 = 640, U0 = 768, VG0 = 1280, GA0 = 1792, GB0 = 2816;
constexpr float LN_EPS = 1e-6f;
constexpr float ALPHA = 1.189207115002721f;

__device__ __forceinline__ float sigmoidf_(float v) { return 1.f / (1.f + __expf(-v)); }
__device__ __forceinline__ float siluf_(float v) { return v * sigmoidf_(v); }
__device__ __forceinline__ float geluf_(float v) { const float z = 0.7978845608028654f * (v + 0.044715f * v * v * v); return v * sigmoidf_(2.f * z); }

__device__ __forceinline__ float block_sum256(float v, float* red) {
#pragma unroll
    for (int o = 32; o > 0; o >>= 1) v += __shfl_xor(v, o);
    const int w = threadIdx.x >> 6;
    __syncthreads();
    if ((threadIdx.x & 63) == 0) red[w] = v;
    __syncthreads();
    return red[0] + red[1] + red[2] + red[3];
}

__global__ void k_mod(const float* c, const float* c_ctx, const float* w_ada, const float* b_ada, float* mod) {
    const int n = blockIdx.x * blockDim.x + threadIdx.x, r = blockIdx.y;
    const float* cv = r < 4 ? c + r * D : c_ctx;
    float acc = 0.f;
    for (int k = 0; k < D; ++k) acc += siluf_(cv[k]) * w_ada[(size_t)k * 6 * D + n];
    mod[r * 6 * D + n] = acc + b_ada[n];
}

__global__ void k_ln_mod(const float* in, const float* shift, const float* scale, float* out) {
    __shared__ float red[4];
    const int row = blockIdx.x, t = threadIdx.x;
    const float* x = in + (size_t)row * D;
    float v[4]; float s = 0.f;
#pragma unroll
    for (int j = 0; j < 4; ++j) { v[j] = x[t + 256 * j]; s += v[j]; }
    const float mean = block_sum256(s, red) * (1.f / D);
    float q = 0.f;
#pragma unroll
    for (int j = 0; j < 4; ++j) { v[j] -= mean; q += v[j] * v[j]; }
    const float rstd = rsqrtf(block_sum256(q, red) * (1.f / D) + LN_EPS);
#pragma unroll
    for (int j = 0; j < 4; ++j) { const int cidx = t + 256 * j; out[(size_t)row * D + cidx] = v[j] * rstd * (1.f + scale[cidx]) + shift[cidx]; }
}

__global__ void k_res_ln(const float* a, const float* bsrc, const float* gate, const float* g, const float* b, float* out) {
    __shared__ float red[4];
    const int row = blockIdx.x, t = threadIdx.x;
    float v[4]; float s = 0.f;
#pragma unroll
    for (int j = 0; j < 4; ++j) { const int cidx = t + 256 * j; v[j] = ALPHA * a[(size_t)row * D + cidx] + gate[cidx] * bsrc[(size_t)row * D + cidx]; s += v[j]; }
    const float mean = block_sum256(s, red) * (1.f / D);
    float q = 0.f;
#pragma unroll
    for (int j = 0; j < 4; ++j) { v[j] -= mean; q += v[j] * v[j]; }
    const float rstd = rsqrtf(block_sum256(q, red) * (1.f / D) + LN_EPS);
#pragma unroll
    for (int j = 0; j < 4; ++j) { const int cidx = t + 256 * j; out[(size_t)row * D + cidx] = v[j] * rstd * g[cidx] + b[cidx]; }
}

__global__ void __launch_bounds__(256) k_gemm(const float* A, int lda, const float* B, int ldb, float* C, int ldc, int K) {
    __shared__ float As[16][65], Bs[16][64];
    const int t = threadIdx.x, tx = t & 15, ty = t >> 4;
    const int m0 = blockIdx.y * 64, n0 = blockIdx.x * 64;
    float acc[4][4];
#pragma unroll
    for (int i = 0; i < 4; ++i)
#pragma unroll
        for (int j = 0; j < 4; ++j) acc[i][j] = 0.f;
    for (int k0 = 0; k0 < K; k0 += 16) {
#pragma unroll
        for (int i = 0; i < 4; ++i) { const int e = t + 256 * i; const int r = e >> 4, kk = e & 15; As[kk][r] = A[(size_t)(m0 + r) * lda + k0 + kk]; }
#pragma unroll
        for (int i = 0; i < 4; ++i) { const int e = t + 256 * i; const int kk = e >> 6, cc = e & 63; Bs[kk][cc] = B[(size_t)(k0 + kk) * ldb + n0 + cc]; }
        __syncthreads();
#pragma unroll
        for (int kk = 0; kk < 16; ++kk) {
            float a[4], b[4];
#pragma unroll
            for (int i = 0; i < 4; ++i) a[i] = As[kk][ty * 4 + i];
#pragma unroll
            for (int j = 0; j < 4; ++j) b[j] = Bs[kk][tx * 4 + j];
#pragma unroll
            for (int i = 0; i < 4; ++i)
#pragma unroll
                for (int j = 0; j < 4; ++j) acc[i][j] += a[i] * b[j];
        }
        __syncthreads();
    }
#pragma unroll
    for (int i = 0; i < 4; ++i)
#pragma unroll
        for (int j = 0; j < 4; ++j) C[(size_t)(m0 + ty * 4 + i) * ldc + n0 + tx * 4 + j] = acc[i][j];
}

__global__ void k_rope_tab(float* tab) {
    const int i = blockIdx.x * blockDim.x + threadIdx.x; if (i >= 128 * 16) return;
    const int pos = i >> 4, f = i & 15;
    const float inv = exp2f(-(float)f * 0.83048202372184f);
    const float angf = (float)pos * inv;
    double a = (double)angf; const double twopi = 6.283185307179586476925;
    double r = a / twopi; r -= __builtin_rint(r); const double x = r * twopi, x2 = x * x;
    double s = 1.0, cterm = 1.0, sterm = 1.0, cs = 1.0;
    s = 1.0; cs = 1.0; sterm = 1.0; cterm = 1.0;
    for (int n = 1; n <= 14; ++n) { cterm *= -x2 / (double)((2 * n - 1) * (2 * n)); sterm *= -x2 / (double)((2 * n) * (2 * n + 1)); cs += cterm; s += sterm; }
    tab[2 * i] = (float)cs; tab[2 * i + 1] = (float)(s * x);
}

__global__ void k_rope(float* p, const float* tab, int rows) {
    const int i = blockIdx.x * blockDim.x + threadIdx.x;
    if (i >= rows * 10 * 32) return;
    const int f = i & 15, half = (i >> 4) & 1, hd = (i >> 5) % 10, t = i / 320;
    const int pos = half == 0 ? (t >> 6) : (t & 63);
    const float cs = tab[2 * (pos * 16 + f)], sn = tab[2 * (pos * 16 + f) + 1];
    float* base = p + (size_t)t * INW + (hd < 8 ? hd * 64 : K0 + (hd - 8) * 64) + half * 32;
    const float xa = base[f], xb = base[f + 16];
    const float sc = hd < 8 ? 0.125f : 1.f;
    base[f] = (xa * cs - xb * sn) * sc; base[f + 16] = (xb * cs + xa * sn) * sc;
}

__global__ void __launch_bounds__(256) k_attn(const float* p, const float* kvc, const float* sink, float* yattn) {
    const int i = blockIdx.x * blockDim.x + threadIdx.x;
    const int h = i & 7, t = i >> 3; if (t >= SEQ) return;
    const int hk = h >> 2;
    float q[64], acc[64];
#pragma unroll
    for (int d = 0; d < 64; ++d) { q[d] = p[(size_t)t * INW + h * 64 + d]; acc[d] = 0.f; }
    float m = sink[h], l = 1.f;
    for (int c = 0; c < CTX; ++c) {
        const float* kr = kvc + (size_t)c * 256 + hk * 64; const float* vr = kr + 128;
        float s = 0.f;
#pragma unroll
        for (int d = 0; d < 64; ++d) s += q[d] * kr[d];
        const float mn = fmaxf(m, s), corr = __expf(m - mn), pe = __expf(s - mn);
        l = l * corr + pe; m = mn;
#pragma unroll
        for (int d = 0; d < 64; ++d) acc[d] = acc[d] * corr + pe * vr[d];
    }
    const int lo = t - 128 < 0 ? 0 : t - 128, hi = t + 128 > SEQ - 1 ? SEQ - 1 : t + 128;
    for (int kp = lo; kp <= hi; ++kp) {
        const float* kr = p + (size_t)kp * INW + K0 + hk * 64; const float* vr = p + (size_t)kp * INW + V0 + hk * 64;
        float s = 0.f;
#pragma unroll
        for (int d = 0; d < 64; ++d) s += q[d] * kr[d];
        const float mn = fmaxf(m, s), corr = __expf(m - mn), pe = __expf(s - mn);
        l = l * corr + pe; m = mn;
#pragma unroll
        for (int d = 0; d < 64; ++d) acc[d] = acc[d] * corr + pe * vr[d];
    }
    const float il = 1.f / l;
#pragma unroll
    for (int d = 0; d < 64; ++d) yattn[(size_t)t * 512 + h * 64 + d] = acc[d] * il;
}

__global__ void k_gm_ln(const float* p, const float* g, const float* b, float* vn) {
    __shared__ float red[4];
    const int row = blockIdx.x, t = threadIdx.x;
    float v[2]; float s = 0.f;
#pragma unroll
    for (int j = 0; j < 2; ++j) { v[j] = geluf_(p[(size_t)row * INW + VG0 + t + 256 * j]); s += v[j]; }
    const float mean = block_sum256(s, red) * (1.f / 512.f);
    float q = 0.f;
#pragma unroll
    for (int j = 0; j < 2; ++j) { v[j] -= mean; q += v[j] * v[j]; }
    const float rstd = rsqrtf(block_sum256(q, red) * (1.f / 512.f) + LN_EPS);
#pragma unroll
    for (int j = 0; j < 2; ++j) { const int cidx = t + 256 * j; vn[(size_t)row * 512 + cidx] = v[j] * rstd * g[cidx] + b[cidx]; }
}
__global__ void k_gm_mix(const float* p, const float* vn, const float* ws, const float* bs, float* ygm) {
    const int i = blockIdx.x * blockDim.x + threadIdx.x;
    const int ch = i & 511, t = i >> 9; if (t >= SEQ) return;
    const int g = ch >> 6, pp = t & 127, ck = t >> 7;
    const float* w = ws + ((size_t)g * 128 + pp) * 128;
    float s = 0.f;
    for (int qq = 0; qq < 128; ++qq) s += w[qq] * vn[(size_t)(ck * 128 + qq) * 512 + ch];
    s += bs[g * 128 + pp];
    ygm[(size_t)t * 512 + ch] = geluf_(p[(size_t)t * INW + U0 + ch]) * s;
}
__global__ void k_merge(const float* p, float* ya, const float* yb, int rows) {
    const size_t i = (size_t)blockIdx.x * blockDim.x + threadIdx.x; if (i >= (size_t)rows * D) return;
    const int cidx = (int)(i & 1023); const size_t t = i >> 10;
    ya[i] = sigmoidf_(p[t * INW + GA0 + cidx]) * ya[i] + sigmoidf_(p[t * INW + GB0 + cidx]) * yb[i];
}

__global__ void k_route(const float* h2, const float* wg, const float* bg, const float* we, const float* be, int* eidx, float* ewt) {
    const int t = blockIdx.x * blockDim.x + threadIdx.x; if (t >= NTOK) return;
    float lg[4] = {0.f, 0.f, 0.f, 0.f}; float le[32];
#pragma unroll
    for (int j = 0; j < 32; ++j) le[j] = 0.f;
    for (int k = 0; k < D; ++k) {
        const float v = h2[(size_t)t * D + k];
#pragma unroll
        for (int j = 0; j < 4; ++j) lg[j] += v * wg[k * 4 + j];
#pragma unroll
        for (int g = 0; g < 4; ++g)
#pragma unroll
            for (int e = 0; e < 8; ++e) le[g * 8 + e] += v * we[((size_t)g * D + k) * 8 + e];
    }
    int gi = 0; float gm = lg[0] + bg[0];
#pragma unroll
    for (int j = 0; j < 4; ++j) lg[j] += bg[j];
#pragma unroll
    for (int j = 1; j < 4; ++j) if (lg[j] > gm) { gm = lg[j]; gi = j; }
    float gs = 0.f;
#pragma unroll
    for (int j = 0; j < 4; ++j) gs += __expf(lg[j] - gm);
    const float gw = 1.f / gs;
    float v8[8];
#pragma unroll
    for (int g = 0; g < 4; ++g) if (g == gi) {
#pragma unroll
        for (int e = 0; e < 8; ++e) v8[e] = le[g * 8 + e] + be[g * 8 + e]; }
    int i1 = 0; float m1 = v8[0];
#pragma unroll
    for (int e = 1; e < 8; ++e) if (v8[e] > m1) { m1 = v8[e]; i1 = e; }
    int i2 = -1; float m2 = -3.0e38f;
#pragma unroll
    for (int e = 0; e < 8; ++e) if (e != i1 && v8[e] > m2) { m2 = v8[e]; i2 = e; }
    const float e2 = __expf(m2 - m1), w1 = 1.f / (1.f + e2), w2 = e2 / (1.f + e2);
    eidx[2 * t] = gi * 8 + i1; eidx[2 * t + 1] = gi * 8 + i2; ewt[2 * t] = gw * w1; ewt[2 * t + 1] = gw * w2;
}
__global__ void __launch_bounds__(256) k_moe(const float* h2, const int* eidx, const float* ewt, const float* w1, const float* w3, const float* w2, float* moe) {
    __shared__ float sx[1024], sh[512];
    const int t = blockIdx.x, tid = threadIdx.x;
#pragma unroll
    for (int j = 0; j < 4; ++j) sx[tid + 256 * j] = h2[(size_t)t * D + tid + 256 * j];
    float out[4] = {0.f, 0.f, 0.f, 0.f};
    for (int kk = 0; kk < 2; ++kk) {
        const int e = eidx[2 * t + kk]; const float wt = ewt[2 * t + kk];
        __syncthreads();
        const float* a1 = w1 + (size_t)e * D * 512; const float* a3 = w3 + (size_t)e * D * 512;
        float h1[2] = {0.f, 0.f}, h3[2] = {0.f, 0.f};
        for (int k = 0; k < D; ++k) { const float v = sx[k];
            h1[0] += v * a1[(size_t)k * 512 + tid]; h1[1] += v * a1[(size_t)k * 512 + tid + 256];
            h3[0] += v * a3[(size_t)k * 512 + tid]; h3[1] += v * a3[(size_t)k * 512 + tid + 256]; }
        sh[tid] = siluf_(h1[0]) * h3[0]; sh[tid + 256] = siluf_(h1[1]) * h3[1];
        __syncthreads();
        const float* a2 = w2 + (size_t)e * 512 * D;
        float y[4] = {0.f, 0.f, 0.f, 0.f};
        for (int j = 0; j < 512; ++j) { const float v = sh[j];
#pragma unroll
            for (int q = 0; q < 4; ++q) y[q] += v * a2[(size_t)j * D + tid + 256 * q]; }
#pragma unroll
        for (int q = 0; q < 4; ++q) out[q] += wt * y[q];
    }
#pragma unroll
    for (int q = 0; q < 4; ++q) moe[(size_t)t * D + tid + 256 * q] = out[q];
}
}

extern "C" void kernel_launch(void* const* d_in, const int* in_sizes, int n_in, void* d_out, int out_size, void* d_ws, size_t ws_size, hipStream_t stream) {
    using namespace nv;
    const float* x = (const float*)d_in[0]; const float* c = (const float*)d_in[1]; const float* ctx = (const float*)d_in[2]; const float* c_ctx = (const float*)d_in[3];
    const float* w_ada = (const float*)d_in[4]; const float* b_ada = (const float*)d_in[5]; const float* w_in = (const float*)d_in[6]; const float* sink = (const float*)d_in[7];
    const float* gm_g = (const float*)d_in[8]; const float* gm_b = (const float*)d_in[9]; const float* gm_ws = (const float*)d_in[10]; const float* gm_bs = (const float*)d_in[11];
    const float* w_pa = (const float*)d_in[12]; const float* w_pb = (const float*)d_in[13]; const float* w_o = (const float*)d_in[14]; const float* ln1_g = (const float*)d_in[15]; const float* ln1_b = (const float*)d_in[16];
    const float* rgw = (const float*)d_in[17]; const float* rgb = (const float*)d_in[18]; const float* rew = (const float*)d_in[19]; const float* reb = (const float*)d_in[20];
    const float* mw1 = (const float*)d_in[21]; const float* mw3 = (const float*)d_in[22]; const float* mw2 = (const float*)d_in[23]; const float* ln2_g = (const float*)d_in[24]; const float* ln2_b = (const float*)d_in[25];
    float* out = (float*)d_out;
    const size_t MiB = 1u << 20;
    if (ws_size < 440 * MiB) { fprintf(stderr, "kernel_launch: workspace too small (%zu)\n", ws_size); return; }
    char* ws = (char*)d_ws;
    float* mod = (float*)(ws);
    float* tab = (float*)(ws + 1 * MiB);
    float* kvc = (float*)(ws + 2 * MiB);
    float* hc = (float*)(ws + 4 * MiB);
    int* eidx = (int*)(ws + 8 * MiB); float* ewt = (float*)(ws + 9 * MiB);
    float* hx = (float*)(ws + 16 * MiB);
    float* p = (float*)(ws + 48 * MiB);
    float* yattn = (float*)(ws + 168 * MiB);
    float* vn = (float*)(ws + 184 * MiB);
    float* ygm = (float*)(ws + 200 * MiB);
    float* ya = (float*)(ws + 216 * MiB);
    float* yb = (float*)(ws + 248 * MiB);
    float* mix = (float*)(ws + 280 * MiB);
    float* h2 = (float*)(ws + 312 * MiB);
    float* moe = (float*)(ws + 16 * MiB);

    hipLaunchKernelGGL(k_mod, dim3(6 * D / 256, 5), dim3(256), 0, stream, c, c_ctx, w_ada, b_ada, mod);
    hipLaunchKernelGGL(k_rope_tab, dim3(8), dim3(256), 0, stream, tab);
    hipLaunchKernelGGL(k_ln_mod, dim3(BATCH * CTX), dim3(256), 0, stream, ctx, mod + 4 * 6 * D, mod + 4 * 6 * D + D, hc);
    hipLaunchKernelGGL(k_gemm, dim3(256 / 64, BATCH * CTX / 64), dim3(256), 0, stream, hc, D, w_in + K0, INW, kvc, 256, D);
    for (int b = 0; b < BATCH; ++b) {
        const float* xb = x + (size_t)b * SEQ * D; const float* md = mod + b * 6 * D;
        hipLaunchKernelGGL(k_ln_mod, dim3(SEQ), dim3(256), 0, stream, xb, md, md + D, hx);
        hipLaunchKernelGGL(k_gemm, dim3(INW / 64, SEQ / 64), dim3(256), 0, stream, hx, D, w_in, INW, p, INW, D);
        hipLaunchKernelGGL(k_rope, dim3(SEQ * 320 / 256), dim3(256), 0, stream, p, tab, SEQ);
        hipLaunchKernelGGL(k_attn, dim3(SEQ * 8 / 256), dim3(256), 0, stream, p, kvc + (size_t)b * CTX * 256, sink, yattn);
        hipLaunchKernelGGL(k_gm_ln, dim3(SEQ), dim3(256), 0, stream, p, gm_g, gm_b, vn);
        hipLaunchKernelGGL(k_gm_mix, dim3(SEQ * 512 / 256), dim3(256), 0, stream, p, vn, gm_ws, gm_bs, ygm);
        hipLaunchKernelGGL(k_gemm, dim3(D / 64, SEQ / 64), dim3(256), 0, stream, yattn, 512, w_pa, D, ya, D, 512);
        hipLaunchKernelGGL(k_gemm, dim3(D / 64, SEQ / 64), dim3(256), 0, stream, ygm, 512, w_pb, D, yb, D, 512);
        hipLaunchKernelGGL(k_merge, dim3(SEQ * D / 256), dim3(256), 0, stream, p, ya, yb, SEQ);
        hipLaunchKernelGGL(k_gemm, dim3(D / 64, SEQ / 64), dim3(256), 0, stream, ya, D, w_o, D, mix, D, D);
        hipLaunchKernelGGL(k_res_ln, dim3(SEQ), dim3(256), 0, stream, xb, mix, md + 2 * D, ln1_g, ln1_b, out + (size_t)b * SEQ * D);
        hipLaunchKernelGGL(k_ln_mod, dim3(SEQ), dim3(256), 0, stream, out + (size_t)b * SEQ * D, md + 3 * D, md + 4 * D, h2 + (size_t)b * SEQ * D);
    }
    hipLaunchKernelGGL(k_route, dim3(NTOK / 256), dim3(256), 0, stream, h2, rgw, rgb, rew, reb, eidx, ewt);
    hipLaunchKernelGGL(k_moe, dim3(NTOK), dim3(256), 0, stream, h2, eidx, ewt, mw1, mw3, mw2, moe);
    for (int b = 0; b < BATCH; ++b) {
        const float* md = mod + b * 6 * D; float* ob = out + (size_t)b * SEQ * D;
        hipLaunchKernelGGL(k_res_ln, dim3(SEQ), dim3(256), 0, stream, ob, moe + (size_t)b * SEQ * D, md + 5 * D, ln2_g, ln2_b, ob);
    }
}
```

```cpp
#include <hip/hip_runtime.h>
#include <cstdio>
#include <cstdint>
namespace pg8 {
#define PG8_LAS __attribute__((address_space(3)))
typedef unsigned short bf16_t;
typedef short bf16x8 __attribute__((ext_vector_type(8)));
typedef float f32x4 __attribute__((ext_vector_type(4)));
typedef unsigned u32x4 __attribute__((ext_vector_type(4)));
constexpr int BM = 256, BK = 64, HALF = 128, HTB = HALF * BK * 2  , STAGE_BYTES = 8 * HTB, NXCD = 8, WGM = 8;

__host__ __device__ __forceinline__ int lds_byte(int r, int c) { const int st = (r >> 4) * 2 + (c >> 5), rr = r & 15, cc = c & 31, ob = rr * 64 + cc * 2; return st * 1024 + (ob ^ (((ob >> 9) & 1) << 5)); }
__host__ __device__ __forceinline__ void stage_rc(int b, int& R, int& C) { const int st = b / 1024, sb = b % 1024, swz = sb ^ (((sb >> 9) & 1) << 5); R = (st >> 1) * 16 + swz / 64; C = (st & 1) * 32 + (swz % 64) / 2; }
__host__ __device__ __forceinline__ int perm32(int rho) { const int n = rho >> 4, i = rho & 15; return 8 * (i >> 2) + 4 * n + (i & 3); }

struct Unit { int pm, pn, pb; };
struct Gemm { const bf16_t* A; const bf16_t* Bt; int M, N, K; };

struct StaticOrder {
    int nM, nN, nwg, G, c;
    __host__ __device__ void init(int M, int N, int G_, int c_) { nM = M / BM; nN = N / BM; nwg = nM * nN; G = G_; c = c_; }
    __host__ __device__ bool next(int i, Unit& u) const {
        const long L = (long)i * G + c; if (L >= nwg) return false;
        int wgid = (int)L; { const int q = nwg / NXCD, r = nwg % NXCD, xcd = wgid % NXCD, off = wgid / NXCD; wgid = (xcd < r ? xcd * (q + 1) : r * (q + 1) + (xcd - r) * q) + off; }
        const int nig = WGM * nN, gid = wgid / nig, fm = gid * WGM, gsz = (nM - fm) < WGM ? (nM - fm) : WGM;
        u.pm = fm + ((wgid % nig) % gsz); u.pn = (wgid % nig) / gsz; u.pb = u.pn; return true;
    }
    __device__ __forceinline__ void a_ready(const Unit&) const {}
    __device__ __forceinline__ void done(const Unit&) const {}
};


__device__ __forceinline__ unsigned cvt_pk_bf16(float lo, float hi) { unsigned r; asm volatile("v_cvt_pk_bf16_f32 %0, %1, %2" : "=v"(r) : "v"(lo), "v"(hi)); return r; }
typedef float f32x2 __attribute__((ext_vector_type(2)));

struct PanelStats {
    unsigned* xbuf;
    unsigned* cnt;
    unsigned* tmo;
    int ntn; float eps;
    unsigned code;
    __device__ __forceinline__ bool run(const f32x4 (&v)[2][2][4][2], const Unit& u, int wr, int wc, int fr, int fq, PG8_LAS unsigned char* lds, int wid, int lane) const {
        typedef float f32x2v __attribute__((ext_vector_type(2)));
        PG8_LAS f32x2v* P = (PG8_LAS f32x2v*)lds;
        PG8_LAS f32x2v* S = (PG8_LAS f32x2v*)(lds + 8192);
        PG8_LAS unsigned* flag = (PG8_LAS unsigned*)(lds + 8192 + 2048);
#pragma unroll
        for (int ai = 0; ai < 2; ++ai)
#pragma unroll
            for (int m = 0; m < 4; ++m) {
                float s = 0.f;
#pragma unroll
                for (int bj = 0; bj < 2; ++bj)
#pragma unroll
                    for (int n = 0; n < 2; ++n) { const f32x4 x = v[ai][bj][m][n]; s += (x[0] + x[1]) + (x[2] + x[3]); }
                s += __shfl_xor(s, 16); s += __shfl_xor(s, 32);
                const float mw = s * (1.0f / 64.0f); float q = 0.f;
#pragma unroll
                for (int bj = 0; bj < 2; ++bj)
#pragma unroll
                    for (int n = 0; n < 2; ++n) { const f32x4 d = v[ai][bj][m][n] - mw; q += (d[0] * d[0] + d[1] * d[1]) + (d[2] * d[2] + d[3] * d[3]); }
                q += __shfl_xor(q, 16); q += __shfl_xor(q, 32);
                if (fq == 0) P[(ai * HALF + wr * 64 + m * 16 + fr) * 4 + wc] = (f32x2v){mw, q};
            }
        asm volatile("s_waitcnt lgkmcnt(0)" ::: "memory"); __builtin_amdgcn_s_barrier(); asm volatile("" ::: "memory");
#if defined(BROKEN_EXCHANGE_NO_WAIT)
#warning BROKEN CONTROL BUILD: the row-statistics exchange does not wait; results are wrong by design
        if (blockIdx.x >= 64) { const long long t0_ = clock64(); while (clock64() - t0_ < 60000) __builtin_amdgcn_s_sleep(8); }
#endif
        const int row = wid * 32 + (lane & 31);
        if (lane < 32) {
            const f32x2v a = P[row * 4 + 0], b = P[row * 4 + 1], c = P[row * 4 + 2], d = P[row * 4 + 3];
            const float mt = (a.x + b.x + c.x + d.x) * 0.25f;
            const float da = a.x - mt, db = b.x - mt, dc = c.x - mt, dd = d.x - mt;
            const float m2 = (a.y + b.y) + (c.y + d.y) + 64.0f * ((da * da + db * db) + (dc * dc + dd * dd));
            unsigned long long* slot = (unsigned long long*)xbuf + ((size_t)(u.pm * BM + row) * 4 + u.pn);
            __hip_atomic_store(slot, ((unsigned long long)__float_as_uint(m2) << 32) | __float_as_uint(mt), __ATOMIC_RELAXED, __HIP_MEMORY_SCOPE_AGENT);
        }
        asm volatile("s_waitcnt vmcnt(0)" ::: "memory");
        if (lane == 0) __hip_atomic_fetch_add(cnt + 64 * u.pm, 1u, __ATOMIC_RELAXED, __HIP_MEMORY_SCOPE_AGENT);
        if (wid == 0) {
            bool dead = false; const unsigned long long t0 = __builtin_amdgcn_s_memrealtime(); const unsigned want = 8u * (unsigned)ntn;
            for (;;) {
#if defined(BROKEN_EXCHANGE_NO_WAIT)
                break;
#endif
                if ((unsigned)__builtin_amdgcn_readfirstlane(__hip_atomic_load(cnt + 64 * u.pm, __ATOMIC_RELAXED, __HIP_MEMORY_SCOPE_AGENT)) >= want) break;
                if (__builtin_amdgcn_s_memrealtime() - t0 > 2000000ull) {
                    if (lane == 0) { unsigned expect = 0u; __hip_atomic_compare_exchange_strong(tmo + 1, &expect, code | (unsigned)(u.pm & 0xff), __ATOMIC_RELAXED, __ATOMIC_RELAXED, __HIP_MEMORY_SCOPE_AGENT);
                                     __hip_atomic_store(tmo, 1u, __ATOMIC_RELAXED, __HIP_MEMORY_SCOPE_AGENT); }
                    dead = true; break; }
                __builtin_amdgcn_s_sleep(2);
            }
            __builtin_amdgcn_fence(__ATOMIC_ACQUIRE, "agent");
            if (lane == 0) flag[0] = dead ? 1u : 0u;
        }
        asm volatile("s_waitcnt vmcnt(0) lgkmcnt(0)" ::: "memory"); __builtin_amdgcn_s_barrier(); asm volatile("" ::: "memory");
        const bool bad = flag[0] != 0u;
        if (lane < 32) {
            const unsigned long long* slot = (const unsigned long long*)xbuf + (size_t)(u.pm * BM + row) * 4; float mt[4], m2[4]; float ms = 0.f;
#pragma unroll
            for (int t = 0; t < 4; ++t) { if (t < ntn) { const unsigned long long w = __hip_atomic_load(slot + t, __ATOMIC_RELAXED, __HIP_MEMORY_SCOPE_AGENT); mt[t] = __uint_as_float((unsigned)w); m2[t] = __uint_as_float((unsigned)(w >> 32)); } else { mt[t] = 0.f; m2[t] = 0.f; } ms += mt[t]; }
            const float mean = ms / (float)ntn; float q = 0.f;
#pragma unroll
            for (int t = 0; t < 4; ++t) if (t < ntn) { const float dm = mt[t] - mean; q += m2[t] + 256.0f * dm * dm; }
            S[row] = (f32x2v){mean, 1.0f / sqrtf(q / (256.0f * (float)ntn) + eps)};
        }
        asm volatile("s_waitcnt lgkmcnt(0)" ::: "memory"); __builtin_amdgcn_s_barrier(); asm volatile("" ::: "memory");
        return bad;
    }
};

template <class Epi, class Sched, bool ALIGN_EPI = false, bool SP2 = false>
__device__ __forceinline__ void gemm_phase(PG8_LAS unsigned char* lds, const Gemm g, const Sched& S, const Epi& E) {
    int tid = threadIdx.x; asm volatile("" : "+v"(tid));
    const int wid = __builtin_amdgcn_readfirstlane(tid >> 6), lane = tid & 63, wr = wid >> 2, wc = wid & 3, fr = lane & 15, fq = lane >> 4;
    const int K = g.K, nt = K / BK;
    unsigned voffA[2], voffB[2];
#pragma unroll
    for (int i = 0; i < 2; ++i) { int R, C; stage_rc(tid * 16 + i * 8192, R, C); const int Rb = Epi::PERM ? ((R & ~31) + perm32(R & 31)) : R;
        voffA[i] = (unsigned)(R * K + C) * 2u; voffB[i] = (unsigned)(Rb * K + C) * 2u; }
    const size_t kstep = (size_t)(BK * 2);
    const size_t hstep = (size_t)HALF * K * 2;
    const size_t tstep = 2 * hstep;
    const unsigned ldsw = (unsigned)wid * 1024u;
    const int aoff = lds_byte(wr * 64 + fr, fq * 8), boff = lds_byte(wc * 32 + fr, fq * 8);
#define PG8_SA(b, h) (((b) * 2 + (h)) * HTB)
#define PG8_SB(b, h) ((4 + (b) * 2 + (h)) * HTB)
#define PG8_STAGE(bufoff, gbase, voff) do { _Pragma("unroll") for (int _i = 0; _i < 2; ++_i) \
        __builtin_amdgcn_global_load_lds((const unsigned*)((const char*)(gbase) + (voff)[_i]), (PG8_LAS unsigned*)(lds + (bufoff) + ldsw + _i * 8192), 16, 0, 0); } while (0)
#define PG8_LDA(dst, b, h) do { _Pragma("unroll") for (int m = 0; m < 4; ++m) _Pragma("unroll") for (int k = 0; k < 2; ++k) dst[m][k] = *(const PG8_LAS bf16x8*)(lds + PG8_SA(b, h) + aoff + m * 2048 + k * 1024); } while (0)
#define PG8_LDB(dst, b, h) do { _Pragma("unroll") for (int n = 0; n < 2; ++n) _Pragma("unroll") for (int k = 0; k < 2; ++k) dst[n][k] = *(const PG8_LAS bf16x8*)(lds + PG8_SB(b, h) + boff + n * 2048 + k * 1024); } while (0)
#define PG8_MMA(ai, bj, At, Bt) do { __builtin_amdgcn_s_setprio(1); _Pragma("unroll") for (int m = 0; m < 4; ++m) _Pragma("unroll") for (int n = 0; n < 2; ++n) _Pragma("unroll") for (int k = 0; k < 2; ++k) \
        acc[ai][bj][m][n] = __builtin_amdgcn_mfma_f32_16x16x32_bf16(Bt[n][k], At[m][k], acc[ai][bj][m][n], 0, 0, 0); __builtin_amdgcn_s_setprio(0); } while (0)
#define PG8_WAIT_V(n) asm volatile("s_waitcnt vmcnt(" #n ")" ::: "memory")
#define PG8_WAIT_L(n) asm volatile("s_waitcnt lgkmcnt(" #n ")" ::: "memory")
#define PG8_BAR __builtin_amdgcn_s_barrier()
#define PG8_SCHED __builtin_amdgcn_sched_barrier(0)
    Unit cur, nxt; int ui = 0;
    if (!S.next(0, cur)) return;
    f32x4 acc[2][2][4][2];
#pragma unroll
    for (int a = 0; a < 2; ++a)
#pragma unroll
        for (int b = 0; b < 2; ++b)
#pragma unroll
            for (int m = 0; m < 4; ++m)
#pragma unroll
                for (int n = 0; n < 2; ++n) acc[a][b][m][n] = (f32x4){0.f, 0.f, 0.f, 0.f};
    bf16x8 At[4][2], B0[2][2], B1[2][2];
    const char* cA = (const char*)g.A + (size_t)cur.pm * tstep; const char* cB = (const char*)g.Bt + (size_t)cur.pb * tstep;
    S.a_ready(cur);
    if constexpr (SP2) {
        PG8_STAGE(PG8_SB(0, 0), cB, voffB); PG8_STAGE(PG8_SB(0, 1), cB + hstep, voffB); PG8_STAGE(PG8_SA(0, 0), cA, voffA); PG8_STAGE(PG8_SA(0, 1), cA + hstep, voffA);
        if (wr == 1) PG8_BAR;
        PG8_WAIT_V(2); PG8_BAR;
        PG8_STAGE(PG8_SB(1, 0), cB + kstep, voffB); PG8_STAGE(PG8_SA(1, 0), cA + kstep, voffA); PG8_STAGE(PG8_SB(1, 1), cB + hstep + kstep, voffB);
        PG8_WAIT_V(6); PG8_BAR;
    } else {
        PG8_STAGE(PG8_SB(0, 0), cB, voffB); PG8_STAGE(PG8_SA(0, 0), cA, voffA); PG8_STAGE(PG8_SB(0, 1), cB + hstep, voffB); PG8_STAGE(PG8_SA(0, 1), cA + hstep, voffA);
        if (wr == 1) PG8_BAR;
        PG8_WAIT_V(4); PG8_BAR;
        PG8_STAGE(PG8_SB(1, 0), cB + kstep, voffB); PG8_STAGE(PG8_SA(1, 0), cA + kstep, voffA); PG8_STAGE(PG8_SB(1, 1), cB + hstep + kstep, voffB);
        PG8_WAIT_V(6); PG8_BAR;
    }
    for (;;) {
        const bool has_next = S.next(ui + 1, nxt);
        const char* nA = has_next ? (const char*)g.A + (size_t)nxt.pm * tstep : cA; const char* nB = has_next ? (const char*)g.Bt + (size_t)nxt.pb * tstep : cB;
        for (int t = 0; t < nt; t += 2) {
            const bool last = (t == nt - 2);
            const char* a1 = cA + (size_t)(t + 1) * kstep;
            const char* a2 = last ? nA : cA + (size_t)(t + 2) * kstep; const char* b2 = last ? nB : cB + (size_t)(t + 2) * kstep;
            const char* a3 = a2 + kstep; const char* b3 = b2 + kstep;
            if (last && has_next) S.a_ready(nxt);
            if constexpr (Epi::MID_T > 0) { if (t == Epi::MID_T) E.mid(acc, cur, wr, wc, fr, fq); }
            if constexpr (SP2) {
            PG8_LDB(B0, 0, 0); PG8_LDB(B1, 0, 1); PG8_SCHED; PG8_LDA(At, 0, 0); PG8_STAGE(PG8_SA(1, 1), a1 + hstep, voffA);
            PG8_WAIT_V(8); PG8_WAIT_L(0); PG8_BAR; PG8_MMA(0, 0, At, B0); PG8_MMA(0, 1, At, B1); PG8_BAR; PG8_SCHED;
            PG8_LDA(At, 0, 1); PG8_STAGE(PG8_SB(0, 0), b2, voffB); PG8_STAGE(PG8_SB(0, 1), b2 + hstep, voffB); PG8_STAGE(PG8_SA(0, 0), a2, voffA);
            PG8_WAIT_V(8); PG8_WAIT_L(0); PG8_BAR; PG8_MMA(1, 0, At, B0); PG8_MMA(1, 1, At, B1); PG8_BAR; PG8_SCHED;
            PG8_LDB(B0, 1, 0); PG8_LDB(B1, 1, 1); PG8_SCHED; PG8_LDA(At, 1, 0); PG8_STAGE(PG8_SA(0, 1), a2 + hstep, voffA);
            PG8_WAIT_V(8); PG8_WAIT_L(0); PG8_BAR; PG8_MMA(0, 0, At, B0); PG8_MMA(0, 1, At, B1); PG8_BAR; PG8_SCHED;
            PG8_LDA(At, 1, 1); PG8_STAGE(PG8_SB(1, 0), b3, voffB); PG8_STAGE(PG8_SB(1, 1), b3 + hstep, voffB); PG8_STAGE(PG8_SA(1, 0), a3, voffA);
            PG8_WAIT_V(8); PG8_WAIT_L(0); PG8_BAR; PG8_MMA(1, 0, At, B0); PG8_MMA(1, 1, At, B1); PG8_BAR; PG8_SCHED;
            } else {
            PG8_LDB(B0, 0, 0); PG8_SCHED; PG8_LDA(At, 0, 0); PG8_STAGE(PG8_SA(1, 1), a1 + hstep, voffA);
            PG8_WAIT_L(8); PG8_BAR; PG8_WAIT_L(0); PG8_MMA(0, 0, At, B0); PG8_BAR; PG8_SCHED;
            PG8_LDB(B1, 0, 1); PG8_STAGE(PG8_SB(0, 0), b2, voffB);
            PG8_BAR; PG8_WAIT_L(0); PG8_MMA(0, 1, At, B1); PG8_BAR;
            PG8_LDA(At, 0, 1); PG8_STAGE(PG8_SA(0, 0), a2, voffA);
            PG8_BAR; PG8_WAIT_L(0); PG8_MMA(1, 0, At, B0); PG8_BAR; PG8_SCHED;
            PG8_STAGE(PG8_SB(0, 1), b2 + hstep, voffB);
            PG8_WAIT_V(6); PG8_BAR; PG8_MMA(1, 1, At, B1); PG8_BAR;
            PG8_LDB(B0, 1, 0); PG8_SCHED; PG8_LDA(At, 1, 0); PG8_STAGE(PG8_SA(0, 1), a2 + hstep, voffA);
            PG8_WAIT_L(8); PG8_BAR; PG8_WAIT_L(0); PG8_MMA(0, 0, At, B0); PG8_BAR; PG8_SCHED;
            PG8_LDB(B1, 1, 1); PG8_STAGE(PG8_SB(1, 0), b3, voffB);
            PG8_BAR; PG8_WAIT_L(0); PG8_MMA(0, 1, At, B1); PG8_BAR;
            PG8_LDA(At, 1, 1); PG8_STAGE(PG8_SA(1, 0), a3, voffA);
            PG8_BAR; PG8_WAIT_L(0); PG8_MMA(1, 0, At, B0); PG8_BAR; PG8_SCHED;
            PG8_STAGE(PG8_SB(1, 1), b3 + hstep, voffB);
            PG8_WAIT_V(6); PG8_BAR; PG8_MMA(1, 1, At, B1); PG8_BAR;
            }
        }
        if constexpr (ALIGN_EPI) { if (wr == 0) PG8_BAR; }
        if constexpr (!Epi::AFTER_DRAIN) { E(acc, cur, wr, wc, fr, fq); S.done(cur); }
        if (!has_next) break;
#pragma unroll
        for (int a = 0; a < 2; ++a)
#pragma unroll
            for (int b = 0; b < 2; ++b)
#pragma unroll
                for (int m = 0; m < 4; ++m)
#pragma unroll
                    for (int n = 0; n < 2; ++n) acc[a][b][m][n] = (f32x4){0.f, 0.f, 0.f, 0.f};
        cur = nxt; cA = nA; cB = nB; ++ui;
        if constexpr (ALIGN_EPI) { if (wr == 1) PG8_BAR; }
    }
    PG8_WAIT_V(0);
    if constexpr (!ALIGN_EPI) { if (wr == 0) PG8_BAR; }
    PG8_BAR;
    if constexpr (Epi::AFTER_DRAIN) { E.fused(acc, cur, wr, wc, fr, fq, lds, wid, lane); S.done(cur); }
#undef PG8_SA
#undef PG8_SB
#undef PG8_STAGE
#undef PG8_LDA
#undef PG8_LDB
#undef PG8_MMA
#undef PG8_WAIT_V
#undef PG8_WAIT_L
#undef PG8_BAR
#undef PG8_SCHED
}
}

#define GAS __attribute__((address_space(1)))
#define LAS __attribute__((address_space(3)))
typedef unsigned short bf16;
typedef unsigned v4u __attribute__((ext_vector_type(4)));
typedef float f32x4 __attribute__((ext_vector_type(4)));
typedef short bf16x8 __attribute__((ext_vector_type(8)));
typedef GAS unsigned gu32;
typedef GAS unsigned long long gu64;
#define RLX_AGENT __ATOMIC_RELAXED, __HIP_MEMORY_SCOPE_AGENT
#define LDS_WAIT() asm volatile("s_waitcnt lgkmcnt(0)" ::: "memory")
#define VM_WAIT() asm volatile("s_waitcnt vmcnt(0)" ::: "memory")
__device__ __forceinline__ unsigned long long rt() { return __builtin_amdgcn_s_memrealtime(); }
__device__ __forceinline__ unsigned f2bf(float f) { unsigned u = __builtin_bit_cast(unsigned, f); return (u + 0x7fffu + ((u >> 16) & 1u)) >> 16; }
__device__ __forceinline__ unsigned pk2(float lo, float hi) { return f2bf(lo) | (f2bf(hi) << 16); }

#define XB_TMO      128
#define XB_XCNT(j)  (256  + 64 * (j))
#define XB_XSUB(j)  (1280 + 64 * (j))
#define XB_XGEN(j)  (2304 + 64 * (j))
#define XB_TOP      3328
#define XB_TOPGEN   3392
#define XCD_BAR_WORDS 3456
#define XB_SPIN_CAP (1u << 20)

__device__ __forceinline__ unsigned xb_ld(unsigned* p)              { return __hip_atomic_load(p, __ATOMIC_RELAXED, __HIP_MEMORY_SCOPE_AGENT); }
__device__ __forceinline__ unsigned xb_add(unsigned* p, unsigned v) { return __hip_atomic_fetch_add(p, v, __ATOMIC_RELAXED, __HIP_MEMORY_SCOPE_AGENT); }
__device__ __forceinline__ unsigned xb_xcc_id() { return (unsigned)__builtin_amdgcn_s_getreg((3 << 11) | 20) & 0xFu; }
#define XB_SPIN(cond, bar) do { unsigned _sp = 0; while (cond) { __builtin_amdgcn_s_sleep(1); \
    if ((++_sp & 255u) == 0u) { if (xb_ld(&(bar)[XB_TMO])) break; if (_sp > XB_SPIN_CAP) { atomicAdd(&(bar)[XB_TMO], 1u); break; } } } } while (0)

struct XcdBarrier {
    unsigned* bar; unsigned x;
    volatile LAS unsigned* st;
};

__device__ __forceinline__ XcdBarrier xcd_barrier_post(unsigned* bar, volatile LAS unsigned* st) {
    XcdBarrier b; b.bar = bar; b.x = xb_xcc_id(); b.st = st;
    if (threadIdx.x == 0) (void)xb_add(&bar[XB_XCNT(b.x)], 1u);
    return b;
}
__device__ __forceinline__ void xcd_barrier_complete(unsigned* bar, unsigned x, unsigned& nloc, unsigned& nx) {
    const unsigned G = gridDim.x * gridDim.y * gridDim.z;
    unsigned sum, cnt, mine, sp = 0u;
    for (;;) {
        sum = 0u; cnt = 0u; mine = 0u;
#pragma unroll
        for (unsigned j = 0; j < 16; ++j) { const unsigned c = xb_ld(&bar[XB_XCNT(j)]); sum += c; cnt += (c > 0u) ? 1u : 0u; mine = (j == x) ? c : mine; }
        if (sum == G) break;
        __builtin_amdgcn_s_sleep(1);
        if ((++sp & 255u) == 0u) { if (xb_ld(&bar[XB_TMO])) break; if (sp > XB_SPIN_CAP) { atomicAdd(&bar[XB_TMO], 1u); break; } }
    }
    nloc = mine > 0u ? mine : 1u; nx = cnt > 0u ? cnt : 1u;
}

__device__ __forceinline__ void xcd_barrier(const XcdBarrier& b) {
    asm volatile("s_waitcnt vmcnt(0)" ::: "memory");
    __syncthreads();
    if (threadIdx.x == 0) {
        unsigned* bar = b.bar;
        __builtin_amdgcn_s_waitcnt(0);
        unsigned nloc = b.st[0], nx = b.st[1];
        if (nloc == 0u) { xcd_barrier_complete(bar, b.x, nloc, nx); b.st[0] = nloc; b.st[1] = nx; }
        const unsigned old = xb_add(&bar[XB_XSUB(b.x)], 1u);
        const unsigned gen = old / nloc;
        if (old + 1u == (gen + 1u) * nloc) {
            __builtin_amdgcn_fence(__ATOMIC_RELEASE, "agent");
            asm volatile("s_waitcnt vmcnt(0)" ::: "memory");
            const unsigned og = xb_add(&bar[XB_TOP], 1u);
            const unsigned tg = og / nx;
            if (og + 1u == (tg + 1u) * nx) xb_add(&bar[XB_TOPGEN], 1u);
            else XB_SPIN(xb_ld(&bar[XB_TOPGEN]) == tg, bar);
            __builtin_amdgcn_fence(__ATOMIC_ACQUIRE, "agent");
            xb_add(&bar[XB_XGEN(b.x)], 1u);
            asm volatile("s_waitcnt vmcnt(0)" ::: "memory");
        } else {
            XB_SPIN(xb_ld(&bar[XB_XGEN(b.x)]) == gen, bar);
            __builtin_amdgcn_fence(__ATOMIC_ACQUIRE, "agent");
            asm volatile("s_waitcnt vmcnt(0)" ::: "memory");
        }
    }
    __syncthreads();
}

namespace mk {
constexpr int D = 1024, BATCH = 4, SEQ = 8192, CTX = 256, NTOK = BATCH * SEQ;
constexpr int INW = 3840, KVB = CTX + SEQ, KVROWS = BATCH * KVB, HROWS = NTOK + BATCH * CTX;
constexpr int NEXP = 32, DEXP = 512, XG_ROWS = 73728, MAXTILES = XG_ROWS / 256;
constexpr float LN_EPS = 1e-6f, ALPHA = 1.189207115002721f, LOG2E = 1.4426950408889634f, QSCALE = 0.125f * 1.4426950408889634f;
constexpr size_t MiB = 1u << 20;
constexpr size_t WS_CTL = 0, CTL_ZERO_BYTES = 1 * MiB;
constexpr size_t WS_MOD = 1 * MiB, WS_TAB = 1 * MiB + 128 * 1024, WS_TILE = 1 * MiB + 192 * 1024;
constexpr size_t WS_TOKSLOT = 1 * MiB + 512 * 1024, TOKSLOT_BYTES = (size_t)XG_ROWS * 4, WS_WTL = WS_TOKSLOT + TOKSLOT_BYTES;
constexpr size_t WS_XCHG = 3 * MiB, WS_EIDX = 5 * MiB, WS_EWT = 5 * MiB + 256 * 1024;
constexpr size_t WS_WIN = 6 * MiB, WS_WPAB = 14 * MiB, WS_WO = 16 * MiB, WS_WSGM = 18 * MiB, WS_RT = 18 * MiB + 512 * 1024, WS_W13 = 20 * MiB, WS_W2 = 84 * MiB;
constexpr size_t WS_H = 116 * MiB;
constexpr size_t WS_Q = 184 * MiB, WS_K = 216 * MiB, WS_V = 226 * MiB, WS_U = 236 * MiB, WS_VG = 268 * MiB, WS_GR = 300 * MiB, WS_GS = 364 * MiB, WS_YCAT = 428 * MiB, WS_END = 492 * MiB;
constexpr size_t WS_V1 = 300 * MiB, WS_X1B = 428 * MiB;
constexpr size_t WS_Y = 184 * MiB, WS_XG = 184 * MiB, WS_HID = 328 * MiB, WS_YSLOT = 184 * MiB;
constexpr int CW_TMO = 0, CW_CODE = 1, CW_BAR = 4096, CW_SEAM = 16384, SEAM_BANK = 128 * 64, CW_CNT = 40960;
constexpr int RING_BYTES = 131072, LDSCTL_OFF = RING_BYTES, MISC_OFF = LDSCTL_OFF + 320, LDS_BYTES = 147456;
constexpr int NWAVES = 8, NTHR = 512;

typedef unsigned short bf16;
typedef unsigned v4u __attribute__((ext_vector_type(4)));
typedef unsigned v2u __attribute__((ext_vector_type(2)));
typedef float f32x4 __attribute__((ext_vector_type(4)));
typedef float f32x2 __attribute__((ext_vector_type(2)));

__device__ __forceinline__ float bflo(unsigned u) { return __builtin_bit_cast(float, u << 16); }
__device__ __forceinline__ float bfhi(unsigned u) { return __builtin_bit_cast(float, u & 0xffff0000u); }
__device__ __forceinline__ float bf2f(bf16 h) { return __builtin_bit_cast(float, (unsigned)h << 16); }
__device__ __forceinline__ unsigned f2bf(float f) { unsigned u = __builtin_bit_cast(unsigned, f); return (u + 0x7fffu + ((u >> 16) & 1u)) >> 16; }
__device__ __forceinline__ unsigned pk2(float lo, float hi) { return f2bf(lo) | (f2bf(hi) << 16); }
__device__ __forceinline__ float fexp2(float v) { return __builtin_amdgcn_exp2f(v); }
__device__ __forceinline__ float frcp(float v) { return __builtin_amdgcn_rcpf(v); }
__device__ __forceinline__ float sigm(float v) { return frcp(1.f + fexp2(-LOG2E * v)); }
__device__ __forceinline__ float silu(float v) { return v * sigm(v); }
__device__ __forceinline__ float gelu_t(float v) { const float z = 0.7978845608028654f * (v + 0.044715f * v * v * v); return v * sigm(2.f * z); }
__device__ __forceinline__ float wave_sum(float v) {
#pragma unroll
    for (int o = 1; o < 64; o <<= 1) v += __shfl_xor(v, o);
    return v;
}
__device__ __forceinline__ int permsrc(int L) { return 16 * ((L >> 2) & 1) + 4 * (L >> 3) + (L & 3); }
__device__ __forceinline__ int krow_of(int m) { return m < NTOK ? (m >> 13) * KVB + CTX + (m & (SEQ - 1)) : ((m - NTOK) >> 8) * KVB + ((m - NTOK) & (CTX - 1)); }

struct Ctx {
    const float* in[26]; float* out; unsigned char* ws;
    int tid, lane, wave, vcu, G;
    LAS unsigned char* lds;
    __device__ __forceinline__ bf16* b16(size_t off) const { return (bf16*)(ws + off); }
    __device__ __forceinline__ float* f32(size_t off) const { return (float*)(ws + off); }
    __device__ __forceinline__ int* i32(size_t off) const { return (int*)(ws + off); }
};

__device__ __forceinline__ void p0_tr_item(const float* W, int ldw, int k0, int srccol0, bf16* WT, int ldt, bool perm, LAS float* scr, int lane) {
#pragma unroll 8
    for (int i = 0; i < 32; ++i) { const int kk = 2 * i + (lane >> 5); scr[kk * 33 + (lane & 31)] = W[(size_t)(k0 + kk) * ldw + srccol0 + (lane & 31)]; }
    LDS_WAIT(); asm volatile("" ::: "memory");
    const int c = lane & 7;
#pragma unroll
    for (int j = 0; j < 4; ++j) { const int n = (lane >> 3) + 8 * j; const int sg = perm ? permsrc(n) : n; const LAS float* s = scr + (8 * c) * 33 + sg;
        v4u o; o.x = pk2(s[0 * 33], s[1 * 33]); o.y = pk2(s[2 * 33], s[3 * 33]); o.z = pk2(s[4 * 33], s[5 * 33]); o.w = pk2(s[6 * 33], s[7 * 33]);
        *(GAS v4u*)(WT + (size_t)n * ldt + 8 * c) = o; }
    LDS_WAIT(); asm volatile("" ::: "memory");
}
__device__ __forceinline__ void p0_prologue(const Ctx& C) {
    const float* c_in = C.in[1]; const float* cctx = C.in[3]; const float* w_ada = C.in[4]; const float* b_ada = C.in[5];
    {
        LAS float* sc = (LAS float*)C.lds;
        LAS float* part = (LAS float*)(C.lds + 32768);
        for (int i = C.tid; i < 5 * D; i += NTHR) { const int r = i >> 10, k = i & 1023; const float v = r < 4 ? c_in[r * D + k] : cctx[k]; sc[i] = silu(v); }
        __syncthreads();
        for (int n0 = C.vcu * 24; n0 < 6 * D; n0 += C.G * 24) {
            const int col = C.tid % 24, ks = C.tid / 24;
            if (ks < 21) {
                float a0 = 0.f, a1 = 0.f, a2 = 0.f, a3 = 0.f, a4 = 0.f;
#pragma unroll 7
                for (int k = ks; k < D; k += 21) { const float w = w_ada[(size_t)k * 6 * D + n0 + col];
                    a0 += sc[k] * w; a1 += sc[D + k] * w; a2 += sc[2 * D + k] * w; a3 += sc[3 * D + k] * w; a4 += sc[4 * D + k] * w; }
                LAS float* p = part + (ks * 5) * 24 + col; p[0] = a0; p[24] = a1; p[48] = a2; p[72] = a3; p[96] = a4;
            }
            __syncthreads();
            if (C.tid < 120) { const int r = C.tid / 24, cc = C.tid % 24; float s = 0.f;
                for (int q = 0; q < 21; ++q) s += part[(q * 5 + r) * 24 + cc];
                C.f32(WS_MOD)[r * 6 * D + n0 + cc] = s + b_ada[n0 + cc]; }
            __syncthreads();
        }
    }
    LAS float* scr = (LAS float*)(C.lds + C.wave * 16384);
    const int gw = C.vcu * NWAVES + C.wave, NGW = C.G * NWAVES;
    constexpr int I_IN = 16 * 120, I_PAB = 512, I_O = 512, I_13 = NEXP * 512, I_2 = NEXP * 256, NITEMS = I_IN + I_PAB + I_O + I_13 + I_2;
    for (int it = gw; it < NITEMS; it += NGW) {
        int r = it;
        if (r < I_IN) { const int kb = r / 120, nb = r % 120, n0 = 32 * nb; int src = n0; bool perm = n0 < 640;
            if (n0 >= 1792) { const int i = (n0 - 1792) >> 8, within = (n0 - 1792) & 255; src = ((within >> 7) ? 2816 : 1792) + 128 * i + (within & 127); }
            p0_tr_item(C.in[6], INW, 64 * kb, src, C.b16(WS_WIN) + (size_t)n0 * D + 64 * kb, D, perm, scr, C.lane); continue; }
        r -= I_IN;
        if (r < I_PAB) { const int which = r >> 8, rr = r & 255, kb = rr >> 5, nb = rr & 31;
            p0_tr_item(which ? C.in[13] : C.in[12], D, 64 * kb, 32 * nb, C.b16(WS_WPAB) + (size_t)(32 * nb) * D + which * 512 + 64 * kb, D, false, scr, C.lane); continue; }
        r -= I_PAB;
        if (r < I_O) { const int kb = r >> 5, nb = r & 31;
            p0_tr_item(C.in[14], D, 64 * kb, 32 * nb, C.b16(WS_WO) + (size_t)(32 * nb) * D + 64 * kb, D, false, scr, C.lane); continue; }
        r -= I_O;
        if (r < I_13) { const int e = r >> 9, rr = r & 511, which = rr >> 8, r2 = rr & 255, kb = r2 >> 4, cb = r2 & 15;
            const int jb = (32 * cb) >> 7, c0 = (32 * cb) & 127, prow = 256 * jb + 128 * which + c0;
            p0_tr_item((which ? C.in[22] : C.in[21]) + (size_t)e * D * DEXP, DEXP, 64 * kb, 32 * cb, C.b16(WS_W13) + ((size_t)e * 1024 + prow) * D + 64 * kb, D, false, scr, C.lane); continue; }
        r -= I_13;
        { const int e = r >> 8, rr = r & 255, kb = rr >> 5, nb = rr & 31;
            p0_tr_item(C.in[23] + (size_t)e * DEXP * D, D, 64 * kb, 32 * nb, C.b16(WS_W2) + ((size_t)e * 1024 + 32 * nb) * DEXP + 64 * kb, DEXP, false, scr, C.lane); }
    }
    const int gt = C.vcu * NTHR + C.tid, NGT = C.G * NTHR;
    for (int i = gt; i < XG_ROWS; i += NGT) C.i32(WS_TOKSLOT)[i] = -1;
    for (int i = gt; i < 8 * 128 * 128; i += NGT) {
        const int kp = i & 127, s = kp >> 4, h = (kp >> 3) & 1, j = kp & 7, q = 16 * s + 8 * (j >> 2) + 4 * h + (j & 3);
        C.b16(WS_WSGM)[i] = (bf16)f2bf(C.in[10][(i & ~127) + q]); }
    for (int i = gt; i < 48 * D; i += NGT) {
        const int e = i >> 10, k = i & 1023; float v = 0.f;
        if (e < 4) v = C.in[17][k * 4 + e]; else if (e < 36) { const int g = (e - 4) >> 3, ee = (e - 4) & 7; v = C.in[19][((size_t)g * D + k) * 8 + ee]; }
        C.b16(WS_RT)[i] = (bf16)f2bf(v); }
    for (int i = gt; i < 128 * 16; i += NGT) {
        const int pos = i >> 4, f = i & 15;
        const float inv = exp2f(-(float)f * 0.83048202372184f); const float angf = (float)pos * inv;
        const double twopi = 6.283185307179586476925; double r = (double)angf / twopi; r -= __builtin_rint(r); const double x = r * twopi, x2 = x * x;
        double s = 1.0, cs = 1.0, sterm = 1.0, cterm = 1.0;
        for (int n = 1; n <= 14; ++n) { cterm *= -x2 / (double)((2 * n - 1) * (2 * n)); sterm *= -x2 / (double)((2 * n) * (2 * n + 1)); cs += cterm; s += sterm; }
        C.f32(WS_TAB)[2 * i] = (float)cs; C.f32(WS_TAB)[2 * i + 1] = (float)(s * x); }
}

__device__ __forceinline__ void ln_mod_row(const float* xrow, const float* sh, const float* sc, bf16* orow, int lane) {
    const GAS f32x4* xr = (const GAS f32x4*)xrow + lane;
    f32x4 v[4]; float s = 0.f;
#pragma unroll
    for (int j = 0; j < 4; ++j) { v[j] = xr[64 * j]; s += (v[j].x + v[j].y) + (v[j].z + v[j].w); }
    const float mean = wave_sum(s) * (1.f / D); float s2 = 0.f;
#pragma unroll
    for (int j = 0; j < 4; ++j) { v[j] = v[j] - mean; s2 += (v[j].x * v[j].x + v[j].y * v[j].y) + (v[j].z * v[j].z + v[j].w * v[j].w); }
    const float rstd = 1.f / sqrtf(wave_sum(s2) * (1.f / D) + LN_EPS);
    GAS v2u* o8 = (GAS v2u*)orow + lane;
#pragma unroll
    for (int j = 0; j < 4; ++j) { const f32x4 a = *((const GAS f32x4*)sc + lane + 64 * j), b = *((const GAS f32x4*)sh + lane + 64 * j);
        const f32x4 o = v[j] * rstd * (a + 1.f) + b; v2u w; w.x = pk2(o.x, o.y); w.y = pk2(o.z, o.w); o8[64 * j] = w; }
}
__device__ __forceinline__ void p1_ln(const Ctx& C) {
    const int gw = C.vcu * NWAVES + C.wave, NGW = C.G * NWAVES; const float* mod = C.f32(WS_MOD);
    for (int m = gw; m < HROWS; m += NGW) {
        const float* src = m < NTOK ? C.in[0] + (size_t)m * D : C.in[2] + (size_t)(m - NTOK) * D;
        const float* md = mod + (m < NTOK ? (m >> 13) : 4) * 6 * D;
        ln_mod_row(src, md, md + D, C.b16(WS_H) + (size_t)m * D, C.lane);
    }
}

__device__ __forceinline__ void p7_gather(const Ctx& C) {
    const int* cnt = (const int*)(C.ws + WS_CTL) + CW_CNT;
    LAS int* part = (LAS int*)C.lds;
    LAS int* tot = part + 512;
    LAS int* base = tot + 32;
    LAS int* off = base + 32;
    LAS int* le = off + 32;
    LAS int* lpos = le + 256;
    { const int e = C.tid & 31, pt = C.tid >> 5; int s = 0; for (int q = 0; q < 16; ++q) s += __hip_atomic_load(cnt + (pt * 16 + q) * 32 + e, __ATOMIC_RELAXED, __HIP_MEMORY_SCOPE_AGENT); part[pt * 32 + e] = s; }
    __syncthreads();
    if (C.tid < 32) { int s = 0; for (int q = 0; q < 16; ++q) s += part[q * 32 + C.tid]; tot[C.tid] = s; }
    __syncthreads();
    if (C.tid == 0) { int b = 0; for (int e = 0; e < 32; ++e) { base[e] = b; b += (tot[e] + 255) & ~255; }
        if (C.vcu == 0) { int* tl = C.i32(WS_TILE); int nt = 0; for (int e = 0; e < 32; ++e) { const int k = (tot[e] + 255) >> 8; for (int q = 0; q < k; ++q) tl[1 + nt + q] = e; nt += k; } tl[0] = nt; } }
    __syncthreads();
    for (int slot = C.vcu; slot < NTOK / 128; slot += C.G) {
        if (C.tid < 32) { int s = base[C.tid]; for (int q = 0; q < slot; ++q) s += __hip_atomic_load(cnt + q * 32 + C.tid, __ATOMIC_RELAXED, __HIP_MEMORY_SCOPE_AGENT); off[C.tid] = s; }
        if (C.tid < 256) le[C.tid] = C.i32(WS_EIDX)[slot * 256 + C.tid];
        __syncthreads();
        if (C.tid < 256) { const int e = le[C.tid]; int r = 0; for (int q = 0; q < C.tid; ++q) r += (le[q] == e) ? 1 : 0; const int pos = off[e] + r; lpos[C.tid] = pos;
            C.i32(WS_TOKSLOT)[pos] = slot * 256 + C.tid; C.f32(WS_WTL)[pos] = C.f32(WS_EWT)[slot * 256 + C.tid]; }
        __syncthreads();
        for (int i0 = C.wave * 32; i0 < C.wave * 32 + 32; i0 += 8) {
            v4u ra[8], rb[8];
#pragma unroll
            for (int q = 0; q < 8; ++q) { const int i = i0 + q, m = slot * 128 + (i >> 1); const GAS v4u* src = (const GAS v4u*)(C.b16(WS_H) + (size_t)m * D); ra[q] = src[C.lane]; rb[q] = src[C.lane + 64]; }
#pragma unroll
            for (int q = 0; q < 8; ++q) { GAS v4u* dst = (GAS v4u*)(C.b16(WS_XG) + (size_t)lpos[i0 + q] * D); dst[C.lane] = ra[q]; dst[C.lane + 64] = rb[q]; }
        }
        __syncthreads();
    }
}
__device__ __forceinline__ void p10_final(const Ctx& C) {
    const int gw = C.vcu * NWAVES + C.wave, NGW = C.G * NWAVES; const float* mod = C.f32(WS_MOD); const float* g = C.in[24]; const float* bb = C.in[25];
#pragma unroll 2
    for (int m = gw; m < NTOK; m += NGW) {
        GAS f32x4* xr = (GAS f32x4*)(C.out + (size_t)m * D) + C.lane; const float* g2 = mod + (m >> 13) * 6 * D + 5 * D;
        const GAS v2u* x1 = (const GAS v2u*)(C.b16(WS_X1B) + (size_t)m * D) + C.lane;
        const GAS v2u* y0 = (const GAS v2u*)(C.b16(WS_YSLOT) + (size_t)(2 * m) * D) + C.lane; const GAS v2u* y1 = (const GAS v2u*)(C.b16(WS_YSLOT) + (size_t)(2 * m + 1) * D) + C.lane;
        f32x4 v[4]; float s = 0.f;
#pragma unroll
        for (int j = 0; j < 4; ++j) { const v2u xx = x1[64 * j]; const v2u a = y0[64 * j], b = y1[64 * j]; const f32x4 gg = *((const GAS f32x4*)g2 + C.lane + 64 * j);
            f32x4 y; y.x = bflo(a.x) + bflo(b.x); y.y = bfhi(a.x) + bfhi(b.x); y.z = bflo(a.y) + bflo(b.y); y.w = bfhi(a.y) + bfhi(b.y);
            f32x4 xv; xv.x = bflo(xx.x); xv.y = bfhi(xx.x); xv.z = bflo(xx.y); xv.w = bfhi(xx.y);
            v[j] = xv * ALPHA + gg * y; s += (v[j].x + v[j].y) + (v[j].z + v[j].w); }
        const float mean = wave_sum(s) * (1.f / D); float s2 = 0.f;
#pragma unroll
        for (int j = 0; j < 4; ++j) { v[j] = v[j] - mean; s2 += (v[j].x * v[j].x + v[j].y * v[j].y) + (v[j].z * v[j].z + v[j].w * v[j].w); }
        const float rstd = 1.f / sqrtf(wave_sum(s2) * (1.f / D) + LN_EPS);
#pragma unroll
        for (int j = 0; j < 4; ++j) { const f32x4 a = *((const GAS f32x4*)g + C.lane + 64 * j), b = *((const GAS f32x4*)bb + C.lane + 64 * j); xr[64 * j] = v[j] * rstd * a + b; }
    }
}

typedef pg8::Unit Unit;
__device__ __forceinline__ v4u pack8(const f32x4 a, const f32x4 b) { v4u w; w.x = pg8::cvt_pk_bf16(a[0], a[1]); w.y = pg8::cvt_pk_bf16(a[2], a[3]); w.z = pg8::cvt_pk_bf16(b[0], b[1]); w.w = pg8::cvt_pk_bf16(b[2], b[3]); return w; }
__device__ __forceinline__ void unpack8(const v4u w, f32x4& a, f32x4& b) { a[0] = bflo(w.x); a[1] = bfhi(w.x); a[2] = bflo(w.y); a[3] = bfhi(w.y); b[0] = bflo(w.z); b[1] = bfhi(w.z); b[2] = bflo(w.w); b[3] = bfhi(w.w); }

struct InProjOrder {
    pg8::StaticOrder so;
    __device__ __forceinline__ void init(int G, int c) { so.init(NTOK, INW, G, c); }
    __device__ __forceinline__ bool next(int i, Unit& u) const {
        if (so.next(i, u)) return true;
        const long L = (long)i * so.G + so.c - so.nwg; if (L < 0 || L >= 4) return false;
        u.pm = NTOK / 256 + (int)L; u.pn = 2; u.pb = 2; return true;
    }
    __device__ __forceinline__ void a_ready(const Unit&) const {}
    __device__ __forceinline__ void done(const Unit&) const {}
};
struct EpiInProj {
    static constexpr bool PERM = true, AFTER_DRAIN = false; static constexpr int MID_T = 0;
    bf16 *Q, *K, *V, *U, *VG, *GR, *GS; const float* tab;
    __device__ __forceinline__ void operator()(const f32x4 (&acc)[2][2][4][2], const Unit& u, int wr, int wc, int fr, int fq) const {
        const int rowb = u.pm * 256 + wr * 64 + fr, cw = wc * 32 + 8 * fq;
        if (u.pn <= 2) {
            const bool isctx = u.pm >= NTOK / 256;
#pragma unroll
            for (int ai = 0; ai < 2; ++ai)
#pragma unroll
                for (int m = 0; m < 4; ++m) {
                    const int row = rowb + ai * 128 + m * 16, t = row & (SEQ - 1), pos = (wc & 1) ? (t & 63) : (t >> 6);
                    f32x4 t0 = (f32x4){1.f, 0.f, 1.f, 0.f}, t1 = t0;
                    if (!isctx) { const GAS f32x4* tp = (const GAS f32x4*)(tab + 2 * (pos * 16 + 4 * fq)); t0 = tp[0]; t1 = tp[1]; }
                    const f32x4 cs = (f32x4){t0[0], t0[2], t1[0], t1[2]}, sn = (f32x4){t0[1], t0[3], t1[1], t1[3]};
                    const int kr = krow_of(row);
#pragma unroll
                    for (int bj = 0; bj < 2; ++bj) {
                        const f32x4 xa = acc[ai][bj][m][0], xb = acc[ai][bj][m][1];
                        if (u.pn == 2 && bj == 1) { *(GAS v4u*)(V + (size_t)kr * 128 + cw) = pack8(xa, xb); }
                        else {
                            f32x4 oa = xa * cs - xb * sn, ob = xb * cs + xa * sn;
                            if (u.pn < 2) { oa = oa * QSCALE; ob = ob * QSCALE; *(GAS v4u*)(Q + (size_t)row * 512 + u.pn * 256 + bj * 128 + cw) = pack8(oa, ob); }
                            else *(GAS v4u*)(K + (size_t)kr * 128 + cw) = pack8(oa, ob);
                        }
                    }
                }
        } else if (u.pn <= 6) {
            bf16* dst = (u.pn < 5 ? U : VG) + ((u.pn - 3) & 1) * 256 + cw;
#pragma unroll
            for (int ai = 0; ai < 2; ++ai)
#pragma unroll
                for (int m = 0; m < 4; ++m) { const int row = rowb + ai * 128 + m * 16;
#pragma unroll
                    for (int bj = 0; bj < 2; ++bj) { f32x4 a = acc[ai][bj][m][0], b = acc[ai][bj][m][1];
#pragma unroll
                        for (int j = 0; j < 4; ++j) { a[j] = gelu_t(a[j]); b[j] = gelu_t(b[j]); }
                        *(GAS v4u*)(dst + (size_t)row * 512 + bj * 128) = pack8(a, b); } }
        } else {
            const int col = 128 * (u.pn - 7) + cw;
#pragma unroll
            for (int ai = 0; ai < 2; ++ai)
#pragma unroll
                for (int m = 0; m < 4; ++m) { const int row = rowb + ai * 128 + m * 16; f32x4 r[2], s[2];
#pragma unroll
                    for (int n = 0; n < 2; ++n)
#pragma unroll
                        for (int j = 0; j < 4; ++j) { const float ea = fexp2(-LOG2E * acc[ai][0][m][n][j]), eb = fexp2(-LOG2E * acc[ai][1][m][n][j]); const float sb = frcp(1.f + eb); s[n][j] = sb; r[n][j] = (1.f + eb) * frcp(1.f + ea); }
                    *(GAS v4u*)(GR + (size_t)row * D + col) = pack8(r[0], r[1]); *(GAS v4u*)(GS + (size_t)row * D + col) = pack8(s[0], s[1]); }
        }
    }
};
__device__ __forceinline__ void p2_inproj(const Ctx& C) {
    pg8::Gemm g{C.b16(WS_H), C.b16(WS_WIN), HROWS, INW, D};
    InProjOrder S; S.init(C.G, (int)blockIdx.x);
    EpiInProj E{C.b16(WS_Q), C.b16(WS_K), C.b16(WS_V), C.b16(WS_U), C.b16(WS_VG), C.b16(WS_GR), C.b16(WS_GS), C.f32(WS_TAB)};
    pg8::gemm_phase<EpiInProj, InProjOrder, true, true>((PG8_LAS unsigned char*)C.lds, g, S, E);
}

struct EpiMerge {
    static constexpr bool PERM = true, AFTER_DRAIN = false; static constexpr int MID_T = 8;
    const bf16 *GR, *GS; bf16* Y;
    __device__ __forceinline__ void mid(f32x4 (&acc)[2][2][4][2], const Unit& u, int wr, int wc, int fr, int fq) const {
        int rowb = u.pm * 256 + wr * 64 + fr, col = u.pn * 256 + wc * 32 + 8 * fq;
        asm volatile("" : "+v"(rowb), "+v"(col));
        v4u w[2][4][2];
#pragma unroll
        for (int ai = 0; ai < 2; ++ai)
#pragma unroll
            for (int m = 0; m < 4; ++m)
#pragma unroll
                for (int bj = 0; bj < 2; ++bj) w[ai][m][bj] = *(const GAS v4u*)(GR + (size_t)(rowb + ai * 128 + m * 16) * D + col + bj * 128);
#pragma unroll
        for (int ai = 0; ai < 2; ++ai)
#pragma unroll
            for (int m = 0; m < 4; ++m)
#pragma unroll
                for (int bj = 0; bj < 2; ++bj) { f32x4 a, b; unpack8(w[ai][m][bj], a, b); acc[ai][bj][m][0] *= a; acc[ai][bj][m][1] *= b; }
    }
    __device__ __forceinline__ void operator()(const f32x4 (&acc)[2][2][4][2], const Unit& u, int wr, int wc, int fr, int fq) const {
        const int rowb = u.pm * 256 + wr * 64 + fr, col = u.pn * 256 + wc * 32 + 8 * fq;
#pragma unroll
        for (int ai = 0; ai < 2; ++ai)
#pragma unroll
            for (int m = 0; m < 4; ++m)
#pragma unroll
                for (int bj = 0; bj < 2; ++bj) { const size_t off = (size_t)(rowb + ai * 128 + m * 16) * D + col + bj * 128; const v4u w = *(const GAS v4u*)(GS + off); f32x4 a, b; unpack8(w, a, b);
                    *(GAS v4u*)(Y + off) = pack8(acc[ai][bj][m][0] * a, acc[ai][bj][m][1] * b); if (bj) asm volatile("" ::: "memory"); }
    }
};
__device__ __forceinline__ void p4_merge(const Ctx& C) {
    pg8::Gemm g{C.b16(WS_YCAT), C.b16(WS_WPAB), NTOK, D, D};
    pg8::StaticOrder S; S.init(NTOK, D, C.G, (int)blockIdx.x);
    EpiMerge E{C.b16(WS_GR), C.b16(WS_GS), C.b16(WS_Y)};
    pg8::gemm_phase<EpiMerge, pg8::StaticOrder, true, true>((PG8_LAS unsigned char*)C.lds, g, S, E);
}

struct MoeOrder {
    const int* tl; int G, c;
    __device__ __forceinline__ bool next(int i, Unit& u) const {
        const int L = i * G + c, nt = tl[0]; if (L >= nt * 4) return false;
        u.pm = L >> 2; u.pn = L & 3; u.pb = tl[1 + (L >> 2)] * 4 + (L & 3); return true;
    }
    __device__ __forceinline__ void a_ready(const Unit&) const {}
    __device__ __forceinline__ void done(const Unit&) const {}
};
struct EpiGateUp {
    static constexpr bool PERM = true, AFTER_DRAIN = false; static constexpr int MID_T = 0;
    bf16* HID;
    __device__ __forceinline__ void operator()(const f32x4 (&acc)[2][2][4][2], const Unit& u, int wr, int wc, int fr, int fq) const {
        const int rowb = u.pm * 256 + wr * 64 + fr, col = u.pn * 128 + wc * 32 + 8 * fq;
#pragma unroll
        for (int ai = 0; ai < 2; ++ai)
#pragma unroll
            for (int m = 0; m < 4; ++m) { f32x4 h[2];
#pragma unroll
                for (int n = 0; n < 2; ++n)
#pragma unroll
                    for (int j = 0; j < 4; ++j) h[n][j] = silu(acc[ai][0][m][n][j]) * acc[ai][1][m][n][j];
                *(GAS v4u*)(HID + (size_t)(rowb + ai * 128 + m * 16) * DEXP + col) = pack8(h[0], h[1]); }
    }
};
struct EpiDown {
    static constexpr bool PERM = true, AFTER_DRAIN = false; static constexpr int MID_T = 0;
    const int* ts; const float* wt; bf16* YS;
    __device__ __forceinline__ void operator()(const f32x4 (&acc)[2][2][4][2], const Unit& u, int wr, int wc, int fr, int fq) const {
        const int rowb = u.pm * 256 + wr * 64 + fr, col = u.pn * 256 + wc * 32 + 8 * fq;
#pragma unroll
        for (int ai = 0; ai < 2; ++ai)
#pragma unroll
            for (int m = 0; m < 4; ++m) { const int row = rowb + ai * 128 + m * 16; const int slot = ts[row]; const float w = wt[row];
                if (slot >= 0) {
#pragma unroll
                    for (int bj = 0; bj < 2; ++bj) *(GAS v4u*)(YS + (size_t)slot * D + col + bj * 128) = pack8(acc[ai][bj][m][0] * w, acc[ai][bj][m][1] * w); } }
    }
};
__device__ __forceinline__ void p8_gateup(const Ctx& C) {
    pg8::Gemm g{C.b16(WS_XG), C.b16(WS_W13), XG_ROWS, 1024, D};
    MoeOrder S{C.i32(WS_TILE), C.G, C.vcu};
    EpiGateUp E{C.b16(WS_HID)};
    pg8::gemm_phase<EpiGateUp, MoeOrder, true, true>((PG8_LAS unsigned char*)C.lds, g, S, E);
}
__device__ __forceinline__ void p9_down(const Ctx& C) {
    pg8::Gemm g{C.b16(WS_HID), C.b16(WS_W2), XG_ROWS, 1024, DEXP};
    MoeOrder S{C.i32(WS_TILE), C.G, C.vcu};
    EpiDown E{C.i32(WS_TOKSLOT), C.f32(WS_WTL), C.b16(WS_YSLOT)};
    pg8::gemm_phase<EpiDown, MoeOrder, true, true>((PG8_LAS unsigned char*)C.lds, g, S, E);
}

struct EpiWoPre {
    static constexpr bool PERM = true, AFTER_DRAIN = false; static constexpr int MID_T = 0;
    const float* x; const float* mod; bf16* V1;
    __device__ __forceinline__ void operator()(const f32x4 (&acc)[2][2][4][2], const Unit& u, int wr, int wc, int fr, int fq) const {
        const int rowb = u.pm * 256 + wr * 64 + fr, col = u.pn * 256 + wc * 32 + 8 * fq;
        const float* g1 = mod + ((u.pm * 256) >> 13) * 6 * D + 2 * D + col;
        f32x4 gv[2][2];
#pragma unroll
        for (int bj = 0; bj < 2; ++bj) { gv[bj][0] = *(const GAS f32x4*)(g1 + bj * 128); gv[bj][1] = *(const GAS f32x4*)(g1 + bj * 128 + 4); }
#pragma unroll
        for (int ai = 0; ai < 2; ++ai) {
            f32x4 xs[4][2][2];
#pragma unroll
            for (int m = 0; m < 4; ++m)
#pragma unroll
                for (int bj = 0; bj < 2; ++bj) { const float* xp = x + (size_t)(rowb + ai * 128 + m * 16) * D + col + bj * 128; xs[m][bj][0] = *(const GAS f32x4*)xp; xs[m][bj][1] = *(const GAS f32x4*)(xp + 4); }
#pragma unroll
            for (int m = 0; m < 4; ++m)
#pragma unroll
                for (int bj = 0; bj < 2; ++bj)
                    *(GAS v4u*)(V1 + (size_t)(rowb + ai * 128 + m * 16) * D + col + bj * 128) = pack8(xs[m][bj][0] * ALPHA + gv[bj][0] * acc[ai][bj][m][0], xs[m][bj][1] * ALPHA + gv[bj][1] * acc[ai][bj][m][1]);
            asm volatile("" ::: "memory");
        }
    }
};
__device__ __forceinline__ void p5_wo(const Ctx& C) {
    pg8::Gemm g{C.b16(WS_Y), C.b16(WS_WO), NTOK, D, D};
    pg8::StaticOrder S; S.init(NTOK, D, C.G, (int)blockIdx.x);
    EpiWoPre E{C.in[0], C.f32(WS_MOD), C.b16(WS_V1)};
    pg8::gemm_phase<EpiWoPre, pg8::StaticOrder, true, true>((PG8_LAS unsigned char*)C.lds, g, S, E);
}

typedef short bf16x8 __attribute__((ext_vector_type(8)));
typedef short s16x4 __attribute__((ext_vector_type(4)));
typedef float f32x16 __attribute__((ext_vector_type(16)));
__device__ __forceinline__ float sum8(const f32x4 a, const f32x4 b) { return ((a[0] + a[1]) + (a[2] + a[3])) + ((b[0] + b[1]) + (b[2] + b[3])); }
__device__ __forceinline__ float sq8(const f32x4 a, const f32x4 b) { return ((a[0] * a[0] + a[1] * a[1]) + (a[2] * a[2] + a[3] * a[3])) + ((b[0] * b[0] + b[1] * b[1]) + (b[2] * b[2] + b[3] * b[3])); }
__device__ __forceinline__ void p5b_rows(const Ctx& C) {
    const bf16* V1 = C.b16(WS_V1); bf16* X1B = C.b16(WS_X1B); bf16* H = C.b16(WS_H); const bf16* RT = C.b16(WS_RT); const float* bg = C.in[18]; const float* be = C.in[20];
    constexpr int RTP = 2064;
    LAS unsigned char* rtl = C.lds;
    LAS float* lg = (LAS float*)(C.lds + 100352 + C.wave * 3200);
    __syncthreads();
    for (int i = C.tid; i < 48 * 128; i += NTHR) { const int e = i >> 7, c = i & 127; *(LAS v4u*)(rtl + e * RTP + c * 16) = *(const GAS v4u*)(RT + (size_t)e * D + c * 8); }
    LDS_WAIT(); __syncthreads();
    const int gw = C.vcu * NWAVES + C.wave, NGW = C.G * NWAVES, lane = C.lane, fr = lane & 15, fq = lane >> 4;
    for (int t0 = gw * 16; t0 < NTOK; t0 += NGW * 16) {
        const float* md = C.f32(WS_MOD) + (t0 >> 13) * 6 * D;
        f32x4 lg1[2][2], lb1[2][2], sc2[2][2], sh2[2][2];
#pragma unroll
        for (int hf = 0; hf < 2; ++hf)
#pragma unroll
            for (int q = 0; q < 2; ++q) { const int c = 512 * hf + 8 * lane + 4 * q;
                lg1[hf][q] = *(const GAS f32x4*)(C.in[15] + c); lb1[hf][q] = *(const GAS f32x4*)(C.in[16] + c); sc2[hf][q] = *(const GAS f32x4*)(md + 4 * D + c) + 1.f; sh2[hf][q] = *(const GAS f32x4*)(md + 3 * D + c); }
#pragma unroll 2
        for (int r = 0; r < 16; ++r) {
            const size_t ro = (size_t)(t0 + r) * D + 8 * lane;
            const v4u w0 = *(const GAS v4u*)(V1 + ro), w1 = *(const GAS v4u*)(V1 + ro + 512);
            f32x4 a[2][2]; unpack8(w0, a[0][0], a[0][1]); unpack8(w1, a[1][0], a[1][1]);
            const float mean = wave_sum(sum8(a[0][0], a[0][1]) + sum8(a[1][0], a[1][1])) * (1.f / D);
#pragma unroll
            for (int hf = 0; hf < 2; ++hf) { a[hf][0] = a[hf][0] - mean; a[hf][1] = a[hf][1] - mean; }
            const float rstd = 1.f / sqrtf(wave_sum(sq8(a[0][0], a[0][1]) + sq8(a[1][0], a[1][1])) * (1.f / D) + LN_EPS);
#pragma unroll
            for (int hf = 0; hf < 2; ++hf) { a[hf][0] = a[hf][0] * rstd * lg1[hf][0] + lb1[hf][0]; a[hf][1] = a[hf][1] * rstd * lg1[hf][1] + lb1[hf][1]; }
            *(GAS v4u*)(X1B + ro) = pack8(a[0][0], a[0][1]); *(GAS v4u*)(X1B + ro + 512) = pack8(a[1][0], a[1][1]);
            const float mean2 = wave_sum(sum8(a[0][0], a[0][1]) + sum8(a[1][0], a[1][1])) * (1.f / D);
#pragma unroll
            for (int hf = 0; hf < 2; ++hf) { a[hf][0] = a[hf][0] - mean2; a[hf][1] = a[hf][1] - mean2; }
            const float rstd2 = 1.f / sqrtf(wave_sum(sq8(a[0][0], a[0][1]) + sq8(a[1][0], a[1][1])) * (1.f / D) + LN_EPS);
#pragma unroll
            for (int hf = 0; hf < 2; ++hf) { a[hf][0] = a[hf][0] * rstd2 * sc2[hf][0] + sh2[hf][0]; a[hf][1] = a[hf][1] * rstd2 * sc2[hf][1] + sh2[hf][1]; }
            *(GAS v4u*)(H + ro) = pack8(a[0][0], a[0][1]); *(GAS v4u*)(H + ro + 512) = pack8(a[1][0], a[1][1]);
        }
        asm volatile("s_waitcnt vmcnt(0)" ::: "memory");
        f32x4 a0 = (f32x4){0.f, 0.f, 0.f, 0.f}, a1 = a0, a2 = a0;
        const bf16* hr = H + (size_t)(t0 + fr) * D + 8 * fq; const LAS unsigned char* rr = rtl + fr * RTP + 16 * fq;
        bf16x8 av[32];
#pragma unroll
        for (int s = 0; s < 32; ++s) av[s] = __builtin_nontemporal_load((const GAS bf16x8*)(hr + 32 * s));
#pragma unroll
        for (int s = 0; s < 32; ++s) {
            const bf16x8 b0 = *(const LAS bf16x8*)(rr + 64 * s), b1 = *(const LAS bf16x8*)(rr + 16 * RTP + 64 * s), b2 = *(const LAS bf16x8*)(rr + 32 * RTP + 64 * s);
            a0 = __builtin_amdgcn_mfma_f32_16x16x32_bf16(av[s], b0, a0, 0, 0, 0); a1 = __builtin_amdgcn_mfma_f32_16x16x32_bf16(av[s], b1, a1, 0, 0, 0); a2 = __builtin_amdgcn_mfma_f32_16x16x32_bf16(av[s], b2, a2, 0, 0, 0);
        }
#pragma unroll
        for (int r = 0; r < 4; ++r) { lg[(4 * fq + r) * 49 + fr] = a0[r]; lg[(4 * fq + r) * 49 + 16 + fr] = a1[r]; lg[(4 * fq + r) * 49 + 32 + fr] = a2[r]; }
        LDS_WAIT(); asm volatile("" ::: "memory");
        if (lane < 16) {
            const LAS float* v = lg + lane * 49; const int m = t0 + lane;
            float g4[4];
#pragma unroll
            for (int j = 0; j < 4; ++j) g4[j] = v[j] + bg[j];
            int gi = 0; float gm = g4[0];
#pragma unroll
            for (int j = 1; j < 4; ++j) if (g4[j] > gm) { gm = g4[j]; gi = j; }
            float gs = 0.f;
#pragma unroll
            for (int j = 0; j < 4; ++j) gs += fexp2((g4[j] - gm) * LOG2E);
            const float gwt = 1.f / gs;
            float v8[8];
#pragma unroll
            for (int e = 0; e < 8; ++e) v8[e] = v[4 + gi * 8 + e] + be[gi * 8 + e];
            int i1 = 0; float m1 = v8[0];
#pragma unroll
            for (int e = 1; e < 8; ++e) if (v8[e] > m1) { m1 = v8[e]; i1 = e; }
            int i2 = 0; float m2 = -3.0e38f;
#pragma unroll
            for (int e = 0; e < 8; ++e) if (e != i1 && v8[e] > m2) { m2 = v8[e]; i2 = e; }
            const float e2 = fexp2((m2 - m1) * LOG2E), w1 = 1.f / (1.f + e2), w2 = e2 / (1.f + e2);
            const int ea = gi * 8 + i1, eb = gi * 8 + i2;
            C.i32(WS_EIDX)[2 * m] = ea; C.i32(WS_EIDX)[2 * m + 1] = eb; C.f32(WS_EWT)[2 * m] = gwt * w1; C.f32(WS_EWT)[2 * m + 1] = gwt * w2;
            int* cnt = (int*)(C.ws + WS_CTL) + CW_CNT + (m >> 7) * 32;
            atomicAdd(cnt + ea, 1); atomicAdd(cnt + eb, 1);
        }
        LDS_WAIT(); asm volatile("" ::: "memory");
    }
}

typedef short v4i16_t __attribute__((ext_vector_type(4)));
__device__ __forceinline__ s16x4 vtr(const LAS unsigned char* p) { return __builtin_bit_cast(s16x4, __builtin_amdgcn_ds_read_tr16_b64_v4i16((LAS v4i16_t*)p)); }
__device__ __forceinline__ int crow(int r, int hi) { return (r & 3) + 8 * (r >> 2) + 4 * hi; }
__device__ __forceinline__ float xhalf_max(float v) { auto rr = __builtin_amdgcn_permlane32_swap(__float_as_uint(v), __float_as_uint(v), false, false); return fmaxf(__uint_as_float(rr[0]), __uint_as_float(rr[1])); }
__device__ __forceinline__ float xhalf_sum(float v) { auto rr = __builtin_amdgcn_permlane32_swap(__float_as_uint(v), __float_as_uint(v), false, false); return __uint_as_float(rr[0]) + __uint_as_float(rr[1]); }
#define MK_VFRAG(vp, off) ({ const s16x4 lo_ = vtr((vp) + (off)), hi_ = vtr((vp) + (off) + 512); (bf16x8){lo_[0], lo_[1], lo_[2], lo_[3], hi_[0], hi_[1], hi_[2], hi_[3]}; })

__device__ __forceinline__ void p3_attn(const Ctx& C) {
    const int lane = C.lane, r32 = lane & 31, hi = lane >> 5, w = C.wave;
    LAS unsigned char* Kb = C.lds; LAS unsigned char* Vb = C.lds + 16384;
    const bf16* Q = C.b16(WS_Q); const bf16* Kg = C.b16(WS_K); const bf16* Vg = C.b16(WS_V); bf16* Y = C.b16(WS_YCAT);
    const int upw = (1024 + C.G - 1) / C.G;
    for (int ui = 0; ui < upw; ++ui) {
        const int u = C.vcu * upw + ui; if (u >= 1024) break;
        const int qb = u & 127, hk = (u >> 7) & 1, b = u >> 8, q0 = qb * 64, h = hk * 4 + (w >> 1), qrel = 32 * (w & 1) + r32;
        const size_t qrow = (size_t)b * SEQ + q0 + qrel;
        bf16x8 qr[4];
#pragma unroll
        for (int d0 = 0; d0 < 4; ++d0) qr[d0] = *(const GAS bf16x8*)(Q + qrow * 512 + h * 64 + 16 * d0 + 8 * hi);
        const int jlo = q0 == 0 ? 2 : (q0 == 64 ? 1 : 0), jhi = q0 == SEQ - 64 ? 2 : (q0 == SEQ - 128 ? 3 : 4), nt = 4 + (jhi - jlo + 1);
        float mx = C.in[7][h] * LOG2E, l = hi ? 0.f : 1.f;
        f32x16 o0, o1;
#pragma unroll
        for (int r = 0; r < 16; ++r) { o0[r] = 0.f; o1[r] = 0.f; }
        const int kvrow0 = b * KVB;
#define MK_TROW(ti) ((ti) < 4 ? kvrow0 + 64 * (ti) : kvrow0 + CTX + q0 - 128 + 64 * (jlo + (ti) - 4))
#define MK_STAGE(ti, buf) do { const int row0_ = MK_TROW(ti); \
        __builtin_amdgcn_global_load_lds((const unsigned*)(Kg + (size_t)(row0_ + lane) * 128 + hk * 64 + 8 * w), (LAS unsigned*)(Kb + (buf) * 8192 + w * 1024), 16, 0, 0); \
        __builtin_amdgcn_global_load_lds((const unsigned*)(Vg + (size_t)(row0_ + 16 * (w & 3) + (lane >> 2)) * 128 + hk * 64 + 32 * (w >> 2) + 8 * (lane & 3)), (LAS unsigned*)(Vb + (buf) * 8192 + w * 1024), 16, 0, 0); } while (0)
        MK_STAGE(0, 0);
        for (int ti = 0; ti < nt; ++ti) {
            const int cur = ti & 1;
            __syncthreads();
            if (ti + 1 < nt) MK_STAGE(ti + 1, cur ^ 1);
            const LAS unsigned char* kb = Kb + cur * 8192 + hi * 1024 + r32 * 16;
            f32x16 p0, p1;
#pragma unroll
            for (int r = 0; r < 16; ++r) { p0[r] = 0.f; p1[r] = 0.f; }
#pragma unroll
            for (int d0 = 0; d0 < 4; ++d0) { const bf16x8 k0 = *(const LAS bf16x8*)(kb + d0 * 2048), k1 = *(const LAS bf16x8*)(kb + d0 * 2048 + 512);
                p0 = __builtin_amdgcn_mfma_f32_32x32x16_bf16(k0, qr[d0], p0, 0, 0, 0); p1 = __builtin_amdgcn_mfma_f32_32x32x16_bf16(k1, qr[d0], p1, 0, 0, 0); }
            if (ti >= 4) { const int j = jlo + ti - 4;
                if (j == 0) {
#pragma unroll
                    for (int r = 0; r < 16; ++r) { const int kk = crow(r, hi); if (kk < qrel) p0[r] = -INFINITY; if (kk + 32 < qrel) p1[r] = -INFINITY; } }
                else if (j == 4) {
#pragma unroll
                    for (int r = 0; r < 16; ++r) { const int kk = crow(r, hi); if (kk > qrel) p0[r] = -INFINITY; if (kk + 32 > qrel) p1[r] = -INFINITY; } } }
            float rm = fmaxf(p0[0], p1[0]);
#pragma unroll
            for (int r = 1; r < 16; ++r) rm = fmaxf(rm, fmaxf(p0[r], p1[r]));
            rm = xhalf_max(rm);
            const float mn = fmaxf(mx, rm), f = fexp2(mx - mn); mx = mn;
            float ls = 0.f;
#pragma unroll
            for (int r = 0; r < 16; ++r) { p0[r] = fexp2(p0[r] - mn); p1[r] = fexp2(p1[r] - mn); ls += p0[r] + p1[r]; }
            l = l * f + ls;
#pragma unroll
            for (int r = 0; r < 16; ++r) { o0[r] *= f; o1[r] *= f; }
            v4u pw[4];
#pragma unroll
            for (int q = 0; q < 4; ++q) { pw[0][q] = pg8::cvt_pk_bf16(p0[2 * q], p0[2 * q + 1]); pw[1][q] = pg8::cvt_pk_bf16(p0[8 + 2 * q], p0[9 + 2 * q]); pw[2][q] = pg8::cvt_pk_bf16(p1[2 * q], p1[2 * q + 1]); pw[3][q] = pg8::cvt_pk_bf16(p1[8 + 2 * q], p1[9 + 2 * q]); }
            const LAS unsigned char* vp = Vb + cur * 8192 + ((lane >> 4) & 1) * 32 + (lane & 3) * 8 + (4 * hi + ((lane & 15) >> 2)) * 64;
#pragma unroll
            for (int ks = 0; ks < 4; ++ks) { const bf16x8 pf = __builtin_bit_cast(bf16x8, pw[ks]);
                const bf16x8 v0 = MK_VFRAG(vp, ks * 1024), v1 = MK_VFRAG(vp, 4096 + ks * 1024);
                o0 = __builtin_amdgcn_mfma_f32_32x32x16_bf16(v0, pf, o0, 0, 0, 0); o1 = __builtin_amdgcn_mfma_f32_32x32x16_bf16(v1, pf, o1, 0, 0, 0); }
        }
        l = xhalf_sum(l); const float il = 1.f / l;
        bf16* yr = Y + qrow * D + h * 64 + 4 * hi;
#pragma unroll
        for (int g4 = 0; g4 < 4; ++g4) { v2u a, c2; a.x = pg8::cvt_pk_bf16(o0[4 * g4] * il, o0[4 * g4 + 1] * il); a.y = pg8::cvt_pk_bf16(o0[4 * g4 + 2] * il, o0[4 * g4 + 3] * il);
            c2.x = pg8::cvt_pk_bf16(o1[4 * g4] * il, o1[4 * g4 + 1] * il); c2.y = pg8::cvt_pk_bf16(o1[4 * g4 + 2] * il, o1[4 * g4 + 3] * il);
            *(GAS v2u*)(yr + 8 * g4) = a; *(GAS v2u*)(yr + 32 + 8 * g4) = c2; }
        __syncthreads();
    }
#undef MK_TROW
#undef MK_STAGE
}

__device__ __forceinline__ void p3_gmlp(const Ctx& C) {
    const int lane = C.lane, r32 = lane & 31, hi = lane >> 5, g = C.wave;
    const bf16* VG = C.b16(WS_VG); const bf16* U = C.b16(WS_U); const bf16* WSG = C.b16(WS_WSGM); bf16* Y = C.b16(WS_YCAT);
    LAS f32x2* stats = (LAS f32x2*)(C.lds + LDSCTL_OFF + 1024);
    LAS unsigned char* img = C.lds + g * 16384;
    for (int ck = C.vcu; ck < NTOK / 128; ck += C.G) {
        const size_t row0 = (size_t)ck * 128;
        __syncthreads();
#pragma unroll 4
        for (int i = 0; i < 16; ++i) { const int q = 16 * g + i; const v4u wv = *(const GAS v4u*)(VG + (row0 + q) * 512 + 8 * lane); f32x4 a, b2; unpack8(wv, a, b2);
            const float s = (a[0] + a[1]) + (a[2] + a[3]) + (b2[0] + b2[1]) + (b2[2] + b2[3]); const float mean = wave_sum(s) * (1.f / 512.f);
            a = a - mean; b2 = b2 - mean; const float q2 = (a[0] * a[0] + a[1] * a[1]) + (a[2] * a[2] + a[3] * a[3]) + (b2[0] * b2[0] + b2[1] * b2[1]) + (b2[2] * b2[2] + b2[3] * b2[3]);
            const float rstd = 1.f / sqrtf(wave_sum(q2) * (1.f / 512.f) + LN_EPS);
            if (lane == 0) stats[q] = (f32x2){mean, rstd}; }
        LDS_WAIT(); __syncthreads();
        { const int cc = lane & 7, ch0 = 64 * g + 8 * cc;
            const f32x4 g0 = *(const GAS f32x4*)(C.in[8] + ch0), g1 = *(const GAS f32x4*)(C.in[8] + ch0 + 4), b0 = *(const GAS f32x4*)(C.in[9] + ch0), b1 = *(const GAS f32x4*)(C.in[9] + ch0 + 4);
#pragma unroll 4
            for (int i = 0; i < 16; ++i) { const int q = 8 * i + (lane >> 3); const v4u wv = *(const GAS v4u*)(VG + (row0 + q) * 512 + ch0); f32x4 a, b2; unpack8(wv, a, b2);
                const f32x2 st = stats[q]; a = (a - st.x) * st.y * g0 + b0; b2 = (b2 - st.x) * st.y * g1 + b1;
                *(LAS v4u*)(img + (cc >> 2) * 8192 + (q >> 4) * 1024 + (q & 15) * 64 + (cc & 3) * 16) = pack8(a, b2); } }
        LDS_WAIT(); asm volatile("" ::: "memory");
        f32x16 acc[4][2];
#pragma unroll
        for (int pt = 0; pt < 4; ++pt)
#pragma unroll
            for (int ct = 0; ct < 2; ++ct)
#pragma unroll
                for (int r = 0; r < 16; ++r) acc[pt][ct][r] = 0.f;
        const LAS unsigned char* vp = img + ((lane >> 4) & 1) * 32 + (lane & 3) * 8 + (4 * hi + ((lane & 15) >> 2)) * 64;
        const bf16* wsr = WSG + ((size_t)g * 128 + r32) * 128 + 8 * hi;
#pragma unroll 2
        for (int ks = 0; ks < 8; ++ks) {
            const bf16x8 v0 = MK_VFRAG(vp, ks * 1024), v1 = MK_VFRAG(vp, 8192 + ks * 1024);
#pragma unroll
            for (int pt = 0; pt < 4; ++pt) { const bf16x8 wf = *(const GAS bf16x8*)(wsr + (size_t)pt * 32 * 128 + 16 * ks);
                acc[pt][0] = __builtin_amdgcn_mfma_f32_32x32x16_bf16(v0, wf, acc[pt][0], 0, 0, 0); acc[pt][1] = __builtin_amdgcn_mfma_f32_32x32x16_bf16(v1, wf, acc[pt][1], 0, 0, 0); }
        }
#pragma unroll
        for (int pt = 0; pt < 4; ++pt) { const int p = 32 * pt + r32; const float bsv = C.in[11][g * 128 + p];
            const bf16* ur = U + (row0 + p) * 512 + 64 * g + 4 * hi; bf16* yr = Y + (row0 + p) * D + 512 + 64 * g + 4 * hi;
#pragma unroll
            for (int ct = 0; ct < 2; ++ct)
#pragma unroll
                for (int g4 = 0; g4 < 4; ++g4) { const v2u uv = *(const GAS v2u*)(ur + 32 * ct + 8 * g4);
                    v2u o; o.x = pg8::cvt_pk_bf16(bflo(uv.x) * (acc[pt][ct][4 * g4] + bsv), bfhi(uv.x) * (acc[pt][ct][4 * g4 + 1] + bsv)); o.y = pg8::cvt_pk_bf16(bflo(uv.y) * (acc[pt][ct][4 * g4 + 2] + bsv), bfhi(uv.y) * (acc[pt][ct][4 * g4 + 3] + bsv));
                    *(GAS v2u*)(yr + 32 * ct + 8 * g4) = o; } }
    }
    __syncthreads();
}

#ifndef REP_PHASE
#define REP_PHASE -1
#endif
struct Args { const float* in[26]; float* out; unsigned char* ws; };
__global__ void __launch_bounds__(NTHR, 2) mk_fwd(Args args) {
    extern __shared__ __attribute__((aligned(16))) unsigned char lds_raw[];
    Ctx C;
#pragma unroll
    for (int i = 0; i < 26; ++i) C.in[i] = args.in[i];
    C.out = args.out; C.ws = args.ws;
    C.lds = (LAS unsigned char*)lds_raw;
    C.tid = threadIdx.x; C.lane = C.tid & 63; C.wave = __builtin_amdgcn_readfirstlane(C.tid >> 6);
    C.G = gridDim.x; { const int bx = blockIdx.x; C.vcu = (C.G % 8 == 0) ? (bx % 8) * (C.G / 8) + bx / 8 : bx; }
    volatile LAS unsigned* MISC = (volatile LAS unsigned*)(C.lds + MISC_OFF);
    for (int u = C.tid; u < (LDS_BYTES - LDSCTL_OFF) / 4; u += NTHR) ((LAS unsigned*)(C.lds + LDSCTL_OFF))[u] = 0u;
    __syncthreads();
    gu32* ctl = (gu32*)(C.ws + WS_CTL);
    XcdBarrier bar = xcd_barrier_post((unsigned*)(ctl + CW_BAR), MISC + 8);
#define GRID_BAR() do { xcd_barrier(bar); C.tid = threadIdx.x; asm volatile("" : "+v"(C.tid)); C.lane = C.tid & 63; } while (0)

    p0_prologue(C); GRID_BAR();
#if REP_PHASE == 0
    p0_prologue(C); GRID_BAR();
#endif
    p1_ln(C); GRID_BAR();
#if REP_PHASE == 1
    p1_ln(C); GRID_BAR();
#endif
    p2_inproj(C);
    GRID_BAR();
#if REP_PHASE == 2
    p2_inproj(C); GRID_BAR();
#endif
    p3_attn(C);
#if REP_PHASE == 30
    p3_attn(C);
#endif
    p3_gmlp(C);
#if REP_PHASE == 31
    p3_gmlp(C);
#endif
    GRID_BAR();
    p4_merge(C);
    GRID_BAR();
#if REP_PHASE == 4
    p4_merge(C); GRID_BAR();
#endif
    p5_wo(C);
    GRID_BAR();
    p5b_rows(C);
    GRID_BAR();
    p7_gather(C); GRID_BAR();
#if REP_PHASE == 7
    p7_gather(C); GRID_BAR();
#endif
    p8_gateup(C);
    GRID_BAR();
#if REP_PHASE == 8
    p8_gateup(C); GRID_BAR();
#endif
    p9_down(C);
    GRID_BAR();
#if REP_PHASE == 9
    p9_down(C); GRID_BAR();
#endif
#if REP_PHASE == 100
    GRID_BAR(); GRID_BAR(); GRID_BAR(); GRID_BAR(); GRID_BAR(); GRID_BAR(); GRID_BAR(); GRID_BAR(); GRID_BAR(); GRID_BAR();
#endif
    p10_final(C);
}
}

extern "C" void kernel_launch(void* const* d_in, const int* in_sizes, int n_in, void* d_out, int out_size, void* d_ws, size_t ws_size, hipStream_t stream) {
    using namespace mk;
    static int grid = 0;
    if (grid == 0) {
        if (n_in != 26 || in_sizes[0] != NTOK * D || out_size != NTOK * D || ws_size < WS_END) {
            fprintf(stderr, "kernel_launch: built for 26 inputs, x/out of %d floats, >= %zu bytes of workspace; got n_in %d, in0 %d, out %d, ws %zu; nothing launched\n", NTOK * D, (size_t)WS_END, n_in, n_in > 0 ? in_sizes[0] : -1, out_size, ws_size);
            grid = -1; return; }
        int dev = 0, cus = 0, per_cu = 0;
        if (hipGetDevice(&dev) != hipSuccess || hipDeviceGetAttribute(&cus, hipDeviceAttributeMultiprocessorCount, dev) != hipSuccess) { fprintf(stderr, "kernel_launch: device query failed\n"); grid = -1; return; }
        if (hipFuncSetAttribute((const void*)mk_fwd, hipFuncAttributeMaxDynamicSharedMemorySize, LDS_BYTES) != hipSuccess) { fprintf(stderr, "kernel_launch: hipFuncSetAttribute failed\n"); grid = -1; return; }
        if (hipOccupancyMaxActiveBlocksPerMultiprocessor(&per_cu, (const void*)mk_fwd, NTHR, LDS_BYTES) != hipSuccess || per_cu < 1) fprintf(stderr, "kernel_launch: note: occupancy query reports %d\n", per_cu);
        (void)hipGetLastError();
        grid = cus;
    }
    if (grid < 0) return;
    if (hipMemsetAsync((char*)d_ws + WS_CTL, 0, 256 * 1024, stream) != hipSuccess) { fprintf(stderr, "kernel_launch: memset failed\n"); return; }
    Args a{};
    for (int i = 0; i < 26; ++i) a.in[i] = (const float*)d_in[i];
    a.out = (float*)d_out; a.ws = (unsigned char*)d_ws;
    hipLaunchKernelGGL(mk_fwd, dim3(grid), dim3(NTHR), LDS_BYTES, stream, a);
    const hipError_t le = hipPeekAtLastError();
    if (le != hipSuccess) fprintf(stderr, "kernel_launch: launch failed: %s\n", hipGetErrorName(le));
}
```

```cpp
#include <hip/hip_runtime.h>
#include <cstdio>
#include <cstdint>
namespace pg8 {
#define PG8_LAS __attribute__((address_space(3)))
typedef unsigned short bf16_t;
typedef short bf16x8 __attribute__((ext_vector_type(8)));
typedef float f32x4 __attribute__((ext_vector_type(4)));
typedef unsigned u32x4 __attribute__((ext_vector_type(4)));
constexpr int BM = 256, BK = 64, HALF = 128, HTB = HALF * BK * 2  , STAGE_BYTES = 8 * HTB, NXCD = 8, WGM = 8;

__host__ __device__ __forceinline__ int lds_byte(int r, int c) { const int st = (r >> 4) * 2 + (c >> 5), rr = r & 15, cc = c & 31, ob = rr * 64 + cc * 2; return st * 1024 + (ob ^ (((ob >> 9) & 1) << 5)); }
__host__ __device__ __forceinline__ void stage_rc(int b, int& R, int& C) { const int st = b / 1024, sb = b % 1024, swz = sb ^ (((sb >> 9) & 1) << 5); R = (st >> 1) * 16 + swz / 64; C = (st & 1) * 32 + (swz % 64) / 2; }
__host__ __device__ __forceinline__ int perm32(int rho) { const int n = rho >> 4, i = rho & 15; return 8 * (i >> 2) + 4 * n + (i & 3); }

struct Unit { int pm, pn, pb; };
struct Gemm { const bf16_t* A; const bf16_t* Bt; int M, N, K; };

struct StaticOrder {
    int nM, nN, nwg, G, c;
    __host__ __device__ void init(int M, int N, int G_, int c_) { nM = M / BM; nN = N / BM; nwg = nM * nN; G = G_; c = c_; }
    __host__ __device__ bool next(int i, Unit& u) const {
        const long L = (long)i * G + c; if (L >= nwg) return false;
        int wgid = (int)L; { const int q = nwg / NXCD, r = nwg % NXCD, xcd = wgid % NXCD, off = wgid / NXCD; wgid = (xcd < r ? xcd * (q + 1) : r * (q + 1) + (xcd - r) * q) + off; }
        const int nig = WGM * nN, gid = wgid / nig, fm = gid * WGM, gsz = (nM - fm) < WGM ? (nM - fm) : WGM;
        u.pm = fm + ((wgid % nig) % gsz); u.pn = (wgid % nig) / gsz; u.pb = u.pn; return true;
    }
    __device__ __forceinline__ void a_ready(const Unit&) const {}
    __device__ __forceinline__ void done(const Unit&) const {}
};


__device__ __forceinline__ unsigned cvt_pk_bf16(float lo, float hi) { unsigned r; asm volatile("v_cvt_pk_bf16_f32 %0, %1, %2" : "=v"(r) : "v"(lo), "v"(hi)); return r; }
typedef float f32x2 __attribute__((ext_vector_type(2)));

struct PanelStats {
    unsigned* xbuf;
    unsigned* cnt;
    unsigned* tmo;
    int ntn; float eps;
    unsigned code;
    __device__ __forceinline__ bool run(const f32x4 (&v)[2][2][4][2], const Unit& u, int wr, int wc, int fr, int fq, PG8_LAS unsigned char* lds, int wid, int lane) const {
        typedef float f32x2v __attribute__((ext_vector_type(2)));
        PG8_LAS f32x2v* P = (PG8_LAS f32x2v*)lds;
        PG8_LAS f32x2v* S = (PG8_LAS f32x2v*)(lds + 8192);
        PG8_LAS unsigned* flag = (PG8_LAS unsigned*)(lds + 8192 + 2048);
#pragma unroll
        for (int ai = 0; ai < 2; ++ai)
#pragma unroll
            for (int m = 0; m < 4; ++m) {
                float s = 0.f;
#pragma unroll
                for (int bj = 0; bj < 2; ++bj)
#pragma unroll
                    for (int n = 0; n < 2; ++n) { const f32x4 x = v[ai][bj][m][n]; s += (x[0] + x[1]) + (x[2] + x[3]); }
                s += __shfl_xor(s, 16); s += __shfl_xor(s, 32);
                const float mw = s * (1.0f / 64.0f); float q = 0.f;
#pragma unroll
                for (int bj = 0; bj < 2; ++bj)
#pragma unroll
                    for (int n = 0; n < 2; ++n) { const f32x4 d = v[ai][bj][m][n] - mw; q += (d[0] * d[0] + d[1] * d[1]) + (d[2] * d[2] + d[3] * d[3]); }
                q += __shfl_xor(q, 16); q += __shfl_xor(q, 32);
                if (fq == 0) P[(ai * HALF + wr * 64 + m * 16 + fr) * 4 + wc] = (f32x2v){mw, q};
            }
        asm volatile("s_waitcnt lgkmcnt(0)" ::: "memory"); __builtin_amdgcn_s_barrier(); asm volatile("" ::: "memory");
#if defined(BROKEN_EXCHANGE_NO_WAIT)
#warning BROKEN CONTROL BUILD: the row-statistics exchange does not wait; results are wrong by design
        if (blockIdx.x >= 64) { const long long t0_ = clock64(); while (clock64() - t0_ < 60000) __builtin_amdgcn_s_sleep(8); }
#endif
        const int row = wid * 32 + (lane & 31);
        if (lane < 32) {
            const f32x2v a = P[row * 4 + 0], b = P[row * 4 + 1], c = P[row * 4 + 2], d = P[row * 4 + 3];
            const float mt = (a.x + b.x + c.x + d.x) * 0.25f;
            const float da = a.x - mt, db = b.x - mt, dc = c.x - mt, dd = d.x - mt;
            const float m2 = (a.y + b.y) + (c.y + d.y) + 64.0f * ((da * da + db * db) + (dc * dc + dd * dd));
            unsigned long long* slot = (unsigned long long*)xbuf + ((size_t)(u.pm * BM + row) * 4 + u.pn);
            __hip_atomic_store(slot, ((unsigned long long)__float_as_uint(m2) << 32) | __float_as_uint(mt), __ATOMIC_RELAXED, __HIP_MEMORY_SCOPE_AGENT);
        }
        asm volatile("s_waitcnt vmcnt(0)" ::: "memory");
        if (lane == 0) __hip_atomic_fetch_add(cnt + 64 * u.pm, 1u, __ATOMIC_RELAXED, __HIP_MEMORY_SCOPE_AGENT);
        if (wid == 0) {
            bool dead = false; const unsigned long long t0 = __builtin_amdgcn_s_memrealtime(); const unsigned want = 8u * (unsigned)ntn;
            for (;;) {
#if defined(BROKEN_EXCHANGE_NO_WAIT)
                break;
#endif
                if ((unsigned)__builtin_amdgcn_readfirstlane(__hip_atomic_load(cnt + 64 * u.pm, __ATOMIC_RELAXED, __HIP_MEMORY_SCOPE_AGENT)) >= want) break;
                if (__builtin_amdgcn_s_memrealtime() - t0 > 2000000ull) {
                    if (lane == 0) { unsigned expect = 0u; __hip_atomic_compare_exchange_strong(tmo + 1, &expect, code | (unsigned)(u.pm & 0xff), __ATOMIC_RELAXED, __ATOMIC_RELAXED, __HIP_MEMORY_SCOPE_AGENT);
                                     __hip_atomic_store(tmo, 1u, __ATOMIC_RELAXED, __HIP_MEMORY_SCOPE_AGENT); }
                    dead = true; break; }
                __builtin_amdgcn_s_sleep(2);
            }
            __builtin_amdgcn_fence(__ATOMIC_ACQUIRE, "agent");
            if (lane == 0) flag[0] = dead ? 1u : 0u;
        }
        asm volatile("s_waitcnt vmcnt(0) lgkmcnt(0)" ::: "memory"); __builtin_amdgcn_s_barrier(); asm volatile("" ::: "memory");
        const bool bad = flag[0] != 0u;
        if (lane < 32) {
            const unsigned long long* slot = (const unsigned long long*)xbuf + (size_t)(u.pm * BM + row) * 4; float mt[4], m2[4]; float ms = 0.f;
#pragma unroll
            for (int t = 0; t < 4; ++t) { if (t < ntn) { const unsigned long long w = __hip_atomic_load(slot + t, __ATOMIC_RELAXED, __HIP_MEMORY_SCOPE_AGENT); mt[t] = __uint_as_float((unsigned)w); m2[t] = __uint_as_float((unsigned)(w >> 32)); } else { mt[t] = 0.f; m2[t] = 0.f; } ms += mt[t]; }
            const float mean = ms / (float)ntn; float q = 0.f;
#pragma unroll
            for (int t = 0; t < 4; ++t) if (t < ntn) { const float dm = mt[t] - mean; q += m2[t] + 256.0f * dm * dm; }
            S[row] = (f32x2v){mean, 1.0f / sqrtf(q / (256.0f * (float)ntn) + eps)};
        }
        asm volatile("s_waitcnt lgkmcnt(0)" ::: "memory"); __builtin_amdgcn_s_barrier(); asm volatile("" ::: "memory");
        return bad;
    }
};

template <class Epi, class Sched, bool ALIGN_EPI = false, bool SP2 = false>
__device__ __forceinline__ void gemm_phase(PG8_LAS unsigned char* lds, const Gemm g, const Sched& S, const Epi& E) {
    int tid = threadIdx.x; asm volatile("" : "+v"(tid));
    const int wid = __builtin_amdgcn_readfirstlane(tid >> 6), lane = tid & 63, wr = wid >> 2, wc = wid & 3, fr = lane & 15, fq = lane >> 4;
    const int K = g.K, nt = K / BK;
    unsigned voffA[2], voffB[2];
#pragma unroll
    for (int i = 0; i < 2; ++i) { int R, C; stage_rc(tid * 16 + i * 8192, R, C); const int Rb = Epi::PERM ? ((R & ~31) + perm32(R & 31)) : R;
        voffA[i] = (unsigned)(R * K + C) * 2u; voffB[i] = (unsigned)(Rb * K + C) * 2u; }
    const size_t kstep = (size_t)(BK * 2);
    const size_t hstep = (size_t)HALF * K * 2;
    const size_t tstep = 2 * hstep;
    const unsigned ldsw = (unsigned)wid * 1024u;
    const int aoff = lds_byte(wr * 64 + fr, fq * 8), boff = lds_byte(wc * 32 + fr, fq * 8);
#define PG8_SA(b, h) (((b) * 2 + (h)) * HTB)
#define PG8_SB(b, h) ((4 + (b) * 2 + (h)) * HTB)
#define PG8_STAGE(bufoff, gbase, voff) do { _Pragma("unroll") for (int _i = 0; _i < 2; ++_i) \
        __builtin_amdgcn_global_load_lds((const unsigned*)((const char*)(gbase) + (voff)[_i]), (PG8_LAS unsigned*)(lds + (bufoff) + ldsw + _i * 8192), 16, 0, 0); } while (0)
#define PG8_LDA(dst, b, h) do { _Pragma("unroll") for (int m = 0; m < 4; ++m) _Pragma("unroll") for (int k = 0; k < 2; ++k) dst[m][k] = *(const PG8_LAS bf16x8*)(lds + PG8_SA(b, h) + aoff + m * 2048 + k * 1024); } while (0)
#define PG8_LDB(dst, b, h) do { _Pragma("unroll") for (int n = 0; n < 2; ++n) _Pragma("unroll") for (int k = 0; k < 2; ++k) dst[n][k] = *(const PG8_LAS bf16x8*)(lds + PG8_SB(b, h) + boff + n * 2048 + k * 1024); } while (0)
#define PG8_MMA(ai, bj, At, Bt) do { __builtin_amdgcn_s_setprio(1); _Pragma("unroll") for (int m = 0; m < 4; ++m) _Pragma("unroll") for (int n = 0; n < 2; ++n) _Pragma("unroll") for (int k = 0; k < 2; ++k) \
        acc[ai][bj][m][n] = __builtin_amdgcn_mfma_f32_16x16x32_bf16(Bt[n][k], At[m][k], acc[ai][bj][m][n], 0, 0, 0); __builtin_amdgcn_s_setprio(0); } while (0)
#define PG8_WAIT_V(n) asm volatile("s_waitcnt vmcnt(" #n ")" ::: "memory")
#define PG8_WAIT_L(n) asm volatile("s_waitcnt lgkmcnt(" #n ")" ::: "memory")
#define PG8_BAR __builtin_amdgcn_s_barrier()
#define PG8_SCHED __builtin_amdgcn_sched_barrier(0)
    Unit cur, nxt; int ui = 0;
    if (!S.next(0, cur)) return;
    f32x4 acc[2][2][4][2];
#pragma unroll
    for (int a = 0; a < 2; ++a)
#pragma unroll
        for (int b = 0; b < 2; ++b)
#pragma unroll
            for (int m = 0; m < 4; ++m)
#pragma unroll
                for (int n = 0; n < 2; ++n) acc[a][b][m][n] = (f32x4){0.f, 0.f, 0.f, 0.f};
    bf16x8 At[4][2], B0[2][2], B1[2][2];
    const char* cA = (const char*)g.A + (size_t)cur.pm * tstep; const char* cB = (const char*)g.Bt + (size_t)cur.pb * tstep;
    S.a_ready(cur);
    if constexpr (SP2) {
        PG8_STAGE(PG8_SB(0, 0), cB, voffB); PG8_STAGE(PG8_SB(0, 1), cB + hstep, voffB); PG8_STAGE(PG8_SA(0, 0), cA, voffA); PG8_STAGE(PG8_SA(0, 1), cA + hstep, voffA);
        if (wr == 1) PG8_BAR;
        PG8_WAIT_V(2); PG8_BAR;
        PG8_STAGE(PG8_SB(1, 0), cB + kstep, voffB); PG8_STAGE(PG8_SA(1, 0), cA + kstep, voffA); PG8_STAGE(PG8_SB(1, 1), cB + hstep + kstep, voffB);
        PG8_WAIT_V(6); PG8_BAR;
    } else {
        PG8_STAGE(PG8_SB(0, 0), cB, voffB); PG8_STAGE(PG8_SA(0, 0), cA, voffA); PG8_STAGE(PG8_SB(0, 1), cB + hstep, voffB); PG8_STAGE(PG8_SA(0, 1), cA + hstep, voffA);
        if (wr == 1) PG8_BAR;
        PG8_WAIT_V(4); PG8_BAR;
        PG8_STAGE(PG8_SB(1, 0), cB + kstep, voffB); PG8_STAGE(PG8_SA(1, 0), cA + kstep, voffA); PG8_STAGE(PG8_SB(1, 1), cB + hstep + kstep, voffB);
        PG8_WAIT_V(6); PG8_BAR;
    }
    for (;;) {
        const bool has_next = S.next(ui + 1, nxt);
        const char* nA = has_next ? (const char*)g.A + (size_t)nxt.pm * tstep : cA; const char* nB = has_next ? (const char*)g.Bt + (size_t)nxt.pb * tstep : cB;
        for (int t = 0; t < nt; t += 2) {
            const bool last = (t == nt - 2);
            const char* a1 = cA + (size_t)(t + 1) * kstep;
            const char* a2 = last ? nA : cA + (size_t)(t + 2) * kstep; const char* b2 = last ? nB : cB + (size_t)(t + 2) * kstep;
            const char* a3 = a2 + kstep; const char* b3 = b2 + kstep;
            if (last && has_next) S.a_ready(nxt);
            if constexpr (Epi::MID_T > 0) { if (t == Epi::MID_T) E.mid(acc, cur, wr, wc, fr, fq); }
            if constexpr (SP2) {
            PG8_LDB(B0, 0, 0); PG8_LDB(B1, 0, 1); PG8_SCHED; PG8_LDA(At, 0, 0); PG8_STAGE(PG8_SA(1, 1), a1 + hstep, voffA);
            PG8_WAIT_V(8); PG8_WAIT_L(0); PG8_BAR; PG8_MMA(0, 0, At, B0); PG8_MMA(0, 1, At, B1); PG8_BAR; PG8_SCHED;
            PG8_LDA(At, 0, 1); PG8_STAGE(PG8_SB(0, 0), b2, voffB); PG8_STAGE(PG8_SB(0, 1), b2 + hstep, voffB); PG8_STAGE(PG8_SA(0, 0), a2, voffA);
            PG8_WAIT_V(8); PG8_WAIT_L(0); PG8_BAR; PG8_MMA(1, 0, At, B0); PG8_MMA(1, 1, At, B1); PG8_BAR; PG8_SCHED;
            PG8_LDB(B0, 1, 0); PG8_LDB(B1, 1, 1); PG8_SCHED; PG8_LDA(At, 1, 0); PG8_STAGE(PG8_SA(0, 1), a2 + hstep, voffA);
            PG8_WAIT_V(8); PG8_WAIT_L(0); PG8_BAR; PG8_MMA(0, 0, At, B0); PG8_MMA(0, 1, At, B1); PG8_BAR; PG8_SCHED;
            PG8_LDA(At, 1, 1); PG8_STAGE(PG8_SB(1, 0), b3, voffB); PG8_STAGE(PG8_SB(1, 1), b3 + hstep, voffB); PG8_STAGE(PG8_SA(1, 0), a3, voffA);
            PG8_WAIT_V(8); PG8_WAIT_L(0); PG8_BAR; PG8_MMA(1, 0, At, B0); PG8_MMA(1, 1, At, B1); PG8_BAR; PG8_SCHED;
            } else {
            PG8_LDB(B0, 0, 0); PG8_SCHED; PG8_LDA(At, 0, 0); PG8_STAGE(PG8_SA(1, 1), a1 + hstep, voffA);
            PG8_WAIT_L(8); PG8_BAR; PG8_WAIT_L(0); PG8_MMA(0, 0, At, B0); PG8_BAR; PG8_SCHED;
            PG8_LDB(B1, 0, 1); PG8_STAGE(PG8_SB(0, 0), b2, voffB);
            PG8_BAR; PG8_WAIT_L(0); PG8_MMA(0, 1, At, B1); PG8_BAR;
            PG8_LDA(At, 0, 1); PG8_STAGE(PG8_SA(0, 0), a2, voffA);
            PG8_BAR; PG8_WAIT_L(0); PG8_MMA(1, 0, At, B0); PG8_BAR; PG8_SCHED;
            PG8_STAGE(PG8_SB(0, 1), b2 + hstep, voffB);
            PG8_WAIT_V(6); PG8_BAR; PG8_MMA(1, 1, At, B1); PG8_BAR;
            PG8_LDB(B0, 1, 0); PG8_SCHED; PG8_LDA(At, 1, 0); PG8_STAGE(PG8_SA(0, 1), a2 + hstep, voffA);
            PG8_WAIT_L(8); PG8_BAR; PG8_WAIT_L(0); PG8_MMA(0, 0, At, B0); PG8_BAR; PG8_SCHED;
            PG8_LDB(B1, 1, 1); PG8_STAGE(PG8_SB(1, 0), b3, voffB);
            PG8_BAR; PG8_WAIT_L(0); PG8_MMA(0, 1, At, B1); PG8_BAR;
            PG8_LDA(At, 1, 1); PG8_STAGE(PG8_SA(1, 0), a3, voffA);
            PG8_BAR; PG8_WAIT_L(0); PG8_MMA(1, 0, At, B0); PG8_BAR; PG8_SCHED;
            PG8_STAGE(PG8_SB(1, 1), b3 + hstep, voffB);
            PG8_WAIT_V(6); PG8_BAR; PG8_MMA(1, 1, At, B1); PG8_BAR;
            }
        }
        if constexpr (ALIGN_EPI) { if (wr == 0) PG8_BAR; }
        if constexpr (!Epi::AFTER_DRAIN) { E(acc, cur, wr, wc, fr, fq); S.done(cur); }
        if (!has_next) break;
#pragma unroll
        for (int a = 0; a < 2; ++a)
#pragma unroll
            for (int b = 0; b < 2; ++b)
#pragma unroll
                for (int m = 0; m < 4; ++m)
#pragma unroll
                    for (int n = 0; n < 2; ++n) acc[a][b][m][n] = (f32x4){0.f, 0.f, 0.f, 0.f};
        cur = nxt; cA = nA; cB = nB; ++ui;
        if constexpr (ALIGN_EPI) { if (wr == 1) PG8_BAR; }
    }
    PG8_WAIT_V(0);
    if constexpr (!ALIGN_EPI) { if (wr == 0) PG8_BAR; }
    PG8_BAR;
    if constexpr (Epi::AFTER_DRAIN) { E.fused(acc, cur, wr, wc, fr, fq, lds, wid, lane); S.done(cur); }
#undef PG8_SA
#undef PG8_SB
#undef PG8_STAGE
#undef PG8_LDA
#undef PG8_LDB
#undef PG8_MMA
#undef PG8_WAIT_V
#undef PG8_WAIT_L
#undef PG8_BAR
#undef PG8_SCHED
}
typedef int i32x4 __attribute__((ext_vector_type(4)));
typedef int i32x8 __attribute__((ext_vector_type(8)));
typedef float f32x16v __attribute__((ext_vector_type(16)));
template <class Epi, class Sched, bool ALIGN_EPI = false, bool SP2 = false>
__device__ __forceinline__ void gemm_phase8(PG8_LAS unsigned char* lds, const Gemm g, const Sched& S, const Epi& E) {
    int tid = threadIdx.x; asm volatile("" : "+v"(tid));
    const int wid = __builtin_amdgcn_readfirstlane(tid >> 6), lane = tid & 63, wr = wid >> 2, wc = wid & 3, fr = lane & 15, fq = lane >> 4;
    const int K = g.K, nt = K / 128;
    unsigned voffA[2], voffB[2];
#pragma unroll
    for (int i = 0; i < 2; ++i) { int R, C; stage_rc(tid * 16 + i * 8192, R, C); const int Rb = Epi::PERM ? ((R & ~31) + perm32(R & 31)) : R;
        voffA[i] = (unsigned)(R * K + 2 * C); voffB[i] = (unsigned)(Rb * K + 2 * C); }
    const size_t kstep = (size_t)(BK * 2);
    const size_t hstep = (size_t)HALF * K;
    const size_t tstep = 2 * hstep;
    const unsigned ldsw = (unsigned)wid * 1024u;
    const int aoff = lds_byte(wr * 64 + fr, fq * 16), boff = lds_byte(wc * 32 + fr, fq * 16);
#define PG8_SA(b, h) (((b) * 2 + (h)) * HTB)
#define PG8_SB(b, h) ((4 + (b) * 2 + (h)) * HTB)
#define PG8_STAGE(bufoff, gbase, voff) do { _Pragma("unroll") for (int _i = 0; _i < 2; ++_i) \
        __builtin_amdgcn_global_load_lds((const unsigned*)((const char*)(gbase) + (voff)[_i]), (PG8_LAS unsigned*)(lds + (bufoff) + ldsw + _i * 8192), 16, 0, 0); } while (0)
#define PG8_LDA(dst, b, h) do { _Pragma("unroll") for (int m = 0; m < 4; ++m) dst[m] = *(const PG8_LAS i32x8*)(lds + PG8_SA(b, h) + aoff + m * 2048); } while (0)
#define PG8_LDB(dst, b, h) do { _Pragma("unroll") for (int n = 0; n < 2; ++n) dst[n] = *(const PG8_LAS i32x8*)(lds + PG8_SB(b, h) + boff + n * 2048); } while (0)
#define PG8_MMA(ai, bj, At, Bt) do { __builtin_amdgcn_s_setprio(1); _Pragma("unroll") for (int m = 0; m < 4; ++m) _Pragma("unroll") for (int n = 0; n < 2; ++n) { \
        const int o_ = 4 * (2 * (bj) + n); f32x4 c_ = (f32x4){acc16[ai][m][o_], acc16[ai][m][o_ + 1], acc16[ai][m][o_ + 2], acc16[ai][m][o_ + 3]}; \
        c_ = __builtin_amdgcn_mfma_scale_f32_16x16x128_f8f6f4(Bt[n], At[m], c_, 0, 0, 0, 0x7F7F7F7F, 0, 0x7F7F7F7F); \
        acc16[ai][m][o_] = c_[0]; acc16[ai][m][o_ + 1] = c_[1]; acc16[ai][m][o_ + 2] = c_[2]; acc16[ai][m][o_ + 3] = c_[3]; } __builtin_amdgcn_s_setprio(0); } while (0)
#define PG8_WAIT_V(n) asm volatile("s_waitcnt vmcnt(" #n ")" ::: "memory")
#define PG8_WAIT_L(n) asm volatile("s_waitcnt lgkmcnt(" #n ")" ::: "memory")
#define PG8_BAR __builtin_amdgcn_s_barrier()
#define PG8_SCHED __builtin_amdgcn_sched_barrier(0)
    Unit cur, nxt; int ui = 0;
    if (!S.next(0, cur)) return;
    f32x16v acc16[2][4];
#pragma unroll
    for (int a = 0; a < 2; ++a)
#pragma unroll
        for (int m = 0; m < 4; ++m) {
#pragma unroll
            for (int e = 0; e < 16; ++e) acc16[a][m][e] = 0.f;
        }
    i32x8 At[4], B0[2], B1[2];
    const char* cA = (const char*)g.A + (size_t)cur.pm * tstep; const char* cB = (const char*)g.Bt + (size_t)cur.pb * tstep;
    S.a_ready(cur);
    if constexpr (SP2) {
        PG8_STAGE(PG8_SB(0, 0), cB, voffB); PG8_STAGE(PG8_SB(0, 1), cB + hstep, voffB); PG8_STAGE(PG8_SA(0, 0), cA, voffA); PG8_STAGE(PG8_SA(0, 1), cA + hstep, voffA);
        if (wr == 1) PG8_BAR;
        PG8_WAIT_V(2); PG8_BAR;
        PG8_STAGE(PG8_SB(1, 0), cB + kstep, voffB); PG8_STAGE(PG8_SA(1, 0), cA + kstep, voffA); PG8_STAGE(PG8_SB(1, 1), cB + hstep + kstep, voffB);
        PG8_WAIT_V(6); PG8_BAR;
    } else {
        PG8_STAGE(PG8_SB(0, 0), cB, voffB); PG8_STAGE(PG8_SA(0, 0), cA, voffA); PG8_STAGE(PG8_SB(0, 1), cB + hstep, voffB); PG8_STAGE(PG8_SA(0, 1), cA + hstep, voffA);
        if (wr == 1) PG8_BAR;
        PG8_WAIT_V(4); PG8_BAR;
        PG8_STAGE(PG8_SB(1, 0), cB + kstep, voffB); PG8_STAGE(PG8_SA(1, 0), cA + kstep, voffA); PG8_STAGE(PG8_SB(1, 1), cB + hstep + kstep, voffB);
        PG8_WAIT_V(6); PG8_BAR;
    }
    for (;;) {
        const bool has_next = S.next(ui + 1, nxt);
        const char* nA = has_next ? (const char*)g.A + (size_t)nxt.pm * tstep : cA; const char* nB = has_next ? (const char*)g.Bt + (size_t)nxt.pb * tstep : cB;
        for (int t = 0; t < nt; t += 2) {
            const bool last = (t == nt - 2);
            const char* a1 = cA + (size_t)(t + 1) * kstep;
            const char* a2 = last ? nA : cA + (size_t)(t + 2) * kstep; const char* b2 = last ? nB : cB + (size_t)(t + 2) * kstep;
            const char* a3 = a2 + kstep; const char* b3 = b2 + kstep;
            if (last && has_next) S.a_ready(nxt);
            if constexpr (SP2) {
            PG8_LDB(B0, 0, 0); PG8_LDB(B1, 0, 1); PG8_SCHED; PG8_LDA(At, 0, 0); PG8_STAGE(PG8_SA(1, 1), a1 + hstep, voffA);
            PG8_WAIT_V(8); PG8_WAIT_L(0); PG8_BAR; PG8_MMA(0, 0, At, B0); PG8_MMA(0, 1, At, B1); PG8_BAR; PG8_SCHED;
            PG8_LDA(At, 0, 1); PG8_STAGE(PG8_SB(0, 0), b2, voffB); PG8_STAGE(PG8_SB(0, 1), b2 + hstep, voffB); PG8_STAGE(PG8_SA(0, 0), a2, voffA);
            PG8_WAIT_V(8); PG8_WAIT_L(0); PG8_BAR; PG8_MMA(1, 0, At, B0); PG8_MMA(1, 1, At, B1); PG8_BAR; PG8_SCHED;
            PG8_LDB(B0, 1, 0); PG8_LDB(B1, 1, 1); PG8_SCHED; PG8_LDA(At, 1, 0); PG8_STAGE(PG8_SA(0, 1), a2 + hstep, voffA);
            PG8_WAIT_V(8); PG8_WAIT_L(0); PG8_BAR; PG8_MMA(0, 0, At, B0); PG8_MMA(0, 1, At, B1); PG8_BAR; PG8_SCHED;
            PG8_LDA(At, 1, 1); PG8_STAGE(PG8_SB(1, 0), b3, voffB); PG8_STAGE(PG8_SB(1, 1), b3 + hstep, voffB); PG8_STAGE(PG8_SA(1, 0), a3, voffA);
            PG8_WAIT_V(8); PG8_WAIT_L(0); PG8_BAR; PG8_MMA(1, 0, At, B0); PG8_MMA(1, 1, At, B1); PG8_BAR; PG8_SCHED;
            } else {
            PG8_LDB(B0, 0, 0); PG8_SCHED; PG8_LDA(At, 0, 0); PG8_STAGE(PG8_SA(1, 1), a1 + hstep, voffA);
            PG8_WAIT_L(8); PG8_BAR; PG8_WAIT_L(0); PG8_MMA(0, 0, At, B0); PG8_BAR; PG8_SCHED;
            PG8_LDB(B1, 0, 1); PG8_STAGE(PG8_SB(0, 0), b2, voffB);
            PG8_BAR; PG8_WAIT_L(0); PG8_MMA(0, 1, At, B1); PG8_BAR;
            PG8_LDA(At, 0, 1); PG8_STAGE(PG8_SA(0, 0), a2, voffA);
            PG8_BAR; PG8_WAIT_L(0); PG8_MMA(1, 0, At, B0); PG8_BAR; PG8_SCHED;
            PG8_STAGE(PG8_SB(0, 1), b2 + hstep, voffB);
            PG8_WAIT_V(6); PG8_BAR; PG8_MMA(1, 1, At, B1); PG8_BAR;
            PG8_LDB(B0, 1, 0); PG8_SCHED; PG8_LDA(At, 1, 0); PG8_STAGE(PG8_SA(0, 1), a2 + hstep, voffA);
            PG8_WAIT_L(8); PG8_BAR; PG8_WAIT_L(0); PG8_MMA(0, 0, At, B0); PG8_BAR; PG8_SCHED;
            PG8_LDB(B1, 1, 1); PG8_STAGE(PG8_SB(1, 0), b3, voffB);
            PG8_BAR; PG8_WAIT_L(0); PG8_MMA(0, 1, At, B1); PG8_BAR;
            PG8_LDA(At, 1, 1); PG8_STAGE(PG8_SA(1, 0), a3, voffA);
            PG8_BAR; PG8_WAIT_L(0); PG8_MMA(1, 0, At, B0); PG8_BAR; PG8_SCHED;
            PG8_STAGE(PG8_SB(1, 1), b3 + hstep, voffB);
            PG8_WAIT_V(6); PG8_BAR; PG8_MMA(1, 1, At, B1); PG8_BAR;
            }
        }
        if constexpr (ALIGN_EPI) { if (wr == 0) PG8_BAR; }
        if constexpr (!Epi::AFTER_DRAIN) { f32x4 acc[2][2][4][2];
_Pragma("unroll") for (int a_ = 0; a_ < 2; ++a_) _Pragma("unroll") for (int b_ = 0; b_ < 2; ++b_) _Pragma("unroll") for (int m_ = 0; m_ < 4; ++m_) _Pragma("unroll") for (int n_ = 0; n_ < 2; ++n_) { const int o_ = 4 * (2 * b_ + n_); acc[a_][b_][m_][n_] = (f32x4){acc16[a_][m_][o_], acc16[a_][m_][o_ + 1], acc16[a_][m_][o_ + 2], acc16[a_][m_][o_ + 3]}; }
          E(acc, cur, wr, wc, fr, fq); S.done(cur); }
        if (!has_next) break;
#pragma unroll
    for (int a = 0; a < 2; ++a)
#pragma unroll
        for (int m = 0; m < 4; ++m) {
#pragma unroll
            for (int e = 0; e < 16; ++e) acc16[a][m][e] = 0.f;
        }
        cur = nxt; cA = nA; cB = nB; ++ui;
        if constexpr (ALIGN_EPI) { if (wr == 1) PG8_BAR; }
    }
    PG8_WAIT_V(0);
    if constexpr (!ALIGN_EPI) { if (wr == 0) PG8_BAR; }
    PG8_BAR;
    static_assert(!Epi::AFTER_DRAIN, "fp8 body: streaming epilogues only");
#undef PG8_SA
#undef PG8_SB
#undef PG8_STAGE
#undef PG8_LDA
#undef PG8_LDB
#undef PG8_MMA
#undef PG8_WAIT_V
#undef PG8_WAIT_L
#undef PG8_BAR
#undef PG8_SCHED
}
}

#define GAS __attribute__((address_space(1)))
#define LAS __attribute__((address_space(3)))
typedef unsigned short bf16;
typedef unsigned v4u __attribute__((ext_vector_type(4)));
typedef float f32x4 __attribute__((ext_vector_type(4)));
typedef short bf16x8 __attribute__((ext_vector_type(8)));
typedef GAS unsigned gu32;
typedef GAS unsigned long long gu64;
#define RLX_AGENT __ATOMIC_RELAXED, __HIP_MEMORY_SCOPE_AGENT
#define LDS_WAIT() asm volatile("s_waitcnt lgkmcnt(0)" ::: "memory")
#define VM_WAIT() asm volatile("s_waitcnt vmcnt(0)" ::: "memory")
__device__ __forceinline__ unsigned long long rt() { return __builtin_amdgcn_s_memrealtime(); }
__device__ __forceinline__ unsigned f2bf(float f) { unsigned u = __builtin_bit_cast(unsigned, f); return (u + 0x7fffu + ((u >> 16) & 1u)) >> 16; }
__device__ __forceinline__ unsigned pk2(float lo, float hi) { return f2bf(lo) | (f2bf(hi) << 16); }

#define XB_TMO      128
#define XB_XCNT(j)  (256  + 64 * (j))
#define XB_XSUB(j)  (1280 + 64 * (j))
#define XB_XGEN(j)  (2304 + 64 * (j))
#define XB_TOP      3328
#define XB_TOPGEN   3392
#define XCD_BAR_WORDS 3456
#define XB_SPIN_CAP (1u << 20)

__device__ __forceinline__ unsigned xb_ld(unsigned* p)              { return __hip_atomic_load(p, __ATOMIC_RELAXED, __HIP_MEMORY_SCOPE_AGENT); }
__device__ __forceinline__ unsigned xb_add(unsigned* p, unsigned v) { return __hip_atomic_fetch_add(p, v, __ATOMIC_RELAXED, __HIP_MEMORY_SCOPE_AGENT); }
__device__ __forceinline__ unsigned xb_xcc_id() { return (unsigned)__builtin_amdgcn_s_getreg((3 << 11) | 20) & 0xFu; }
#define XB_SPIN(cond, bar) do { unsigned _sp = 0; while (cond) { __builtin_amdgcn_s_sleep(1); \
    if ((++_sp & 255u) == 0u) { if (xb_ld(&(bar)[XB_TMO])) break; if (_sp > XB_SPIN_CAP) { atomicAdd(&(bar)[XB_TMO], 1u); break; } } } } while (0)

struct XcdBarrier {
    unsigned* bar; unsigned x;
    volatile LAS unsigned* st;
};

__device__ __forceinline__ XcdBarrier xcd_barrier_post(unsigned* bar, volatile LAS unsigned* st) {
    XcdBarrier b; b.bar = bar; b.x = xb_xcc_id(); b.st = st;
    if (threadIdx.x == 0) (void)xb_add(&bar[XB_XCNT(b.x)], 1u);
    return b;
}
__device__ __forceinline__ void xcd_barrier_complete(unsigned* bar, unsigned x, unsigned& nloc, unsigned& nx) {
    const unsigned G = gridDim.x * gridDim.y * gridDim.z;
    unsigned sum, cnt, mine, sp = 0u;
    for (;;) {
        sum = 0u; cnt = 0u; mine = 0u;
#pragma unroll
        for (unsigned j = 0; j < 16; ++j) { const unsigned c = xb_ld(&bar[XB_XCNT(j)]); sum += c; cnt += (c > 0u) ? 1u : 0u; mine = (j == x) ? c : mine; }
        if (sum == G) break;
        __builtin_amdgcn_s_sleep(1);
        if ((++sp & 255u) == 0u) { if (xb_ld(&bar[XB_TMO])) break; if (sp > XB_SPIN_CAP) { atomicAdd(&bar[XB_TMO], 1u); break; } }
    }
    nloc = mine > 0u ? mine : 1u; nx = cnt > 0u ? cnt : 1u;
}

__device__ __forceinline__ void xcd_barrier(const XcdBarrier& b) {
    asm volatile("s_waitcnt vmcnt(0)" ::: "memory");
    __syncthreads();
    if (threadIdx.x == 0) {
        unsigned* bar = b.bar;
        __builtin_amdgcn_s_waitcnt(0);
        unsigned nloc = b.st[0], nx = b.st[1];
        if (nloc == 0u) { xcd_barrier_complete(bar, b.x, nloc, nx); b.st[0] = nloc; b.st[1] = nx; }
        const unsigned old = xb_add(&bar[XB_XSUB(b.x)], 1u);
        const unsigned gen = old / nloc;
        if (old + 1u == (gen + 1u) * nloc) {
            __builtin_amdgcn_fence(__ATOMIC_RELEASE, "agent");
            asm volatile("s_waitcnt vmcnt(0)" ::: "memory");
            const unsigned og = xb_add(&bar[XB_TOP], 1u);
            const unsigned tg = og / nx;
            if (og + 1u == (tg + 1u) * nx) xb_add(&bar[XB_TOPGEN], 1u);
            else XB_SPIN(xb_ld(&bar[XB_TOPGEN]) == tg, bar);
            __builtin_amdgcn_fence(__ATOMIC_ACQUIRE, "agent");
            xb_add(&bar[XB_XGEN(b.x)], 1u);
            asm volatile("s_waitcnt vmcnt(0)" ::: "memory");
        } else {
            XB_SPIN(xb_ld(&bar[XB_XGEN(b.x)]) == gen, bar);
            __builtin_amdgcn_fence(__ATOMIC_ACQUIRE, "agent");
            asm volatile("s_waitcnt vmcnt(0)" ::: "memory");
        }
    }
    __syncthreads();
}

namespace mk {
constexpr int D = 1024, BATCH = 4, SEQ = 8192, CTX = 256, NTOK = BATCH * SEQ;
constexpr int INW = 3840, KVB = CTX + SEQ, KVROWS = BATCH * KVB, HROWS = NTOK + BATCH * CTX;
constexpr int NEXP = 32, DEXP = 512, XG_ROWS = 73728, MAXTILES = XG_ROWS / 256;
constexpr float LN_EPS = 1e-6f, ALPHA = 1.189207115002721f, LOG2E = 1.4426950408889634f, QSCALE = 0.125f * 1.4426950408889634f;
constexpr size_t MiB = 1u << 20;
constexpr size_t WS_CTL = 0, CTL_ZERO_BYTES = 1 * MiB;
constexpr size_t WS_MOD = 1 * MiB, WS_TAB = 1 * MiB + 128 * 1024, WS_TILE = 1 * MiB + 192 * 1024;
constexpr size_t WS_TOKSLOT = 1 * MiB + 512 * 1024, TOKSLOT_BYTES = (size_t)XG_ROWS * 4, WS_WTL = WS_TOKSLOT + TOKSLOT_BYTES;
constexpr size_t WS_XCHG = 3 * MiB, WS_EIDX = 5 * MiB, WS_EWT = 5 * MiB + 256 * 1024;
constexpr size_t WS_WIN = 6 * MiB, WS_WPAB = 14 * MiB, WS_WO = 16 * MiB, WS_WSGM = 18 * MiB, WS_RT = 18 * MiB + 512 * 1024, WS_W13 = 20 * MiB, WS_W2 = 84 * MiB;
constexpr size_t WS_H8 = 116 * MiB, WS_H = 364 * MiB;
constexpr size_t WS_Q = 184 * MiB, WS_K = 216 * MiB, WS_V = 226 * MiB, WS_U = 236 * MiB, WS_VG = 268 * MiB, WS_GR = 300 * MiB, WS_GS = 364 * MiB, WS_YCAT = 428 * MiB, WS_END = 492 * MiB;
constexpr size_t WS_V1 = 300 * MiB, WS_X1B = 428 * MiB;
constexpr size_t WS_Y = 184 * MiB, WS_XG = 184 * MiB, WS_HID = 328 * MiB, WS_YSLOT = 184 * MiB;
constexpr int CW_TMO = 0, CW_CODE = 1, CW_BAR = 4096, CW_SEAM = 16384, SEAM_BANK = 128 * 64, CW_CNT = 40960;
constexpr int RING_BYTES = 131072, LDSCTL_OFF = RING_BYTES, MISC_OFF = LDSCTL_OFF + 320, LDS_BYTES = 147456;
constexpr int NWAVES = 8, NTHR = 512;

typedef unsigned short bf16;
typedef unsigned v4u __attribute__((ext_vector_type(4)));
typedef unsigned v2u __attribute__((ext_vector_type(2)));
typedef float f32x4 __attribute__((ext_vector_type(4)));
typedef float f32x2 __attribute__((ext_vector_type(2)));

__device__ __forceinline__ float bflo(unsigned u) { return __builtin_bit_cast(float, u << 16); }
__device__ __forceinline__ float bfhi(unsigned u) { return __builtin_bit_cast(float, u & 0xffff0000u); }
__device__ __forceinline__ float bf2f(bf16 h) { return __builtin_bit_cast(float, (unsigned)h << 16); }
__device__ __forceinline__ unsigned f2bf(float f) { unsigned u = __builtin_bit_cast(unsigned, f); return (u + 0x7fffu + ((u >> 16) & 1u)) >> 16; }
__device__ __forceinline__ unsigned pk2(float lo, float hi) { return f2bf(lo) | (f2bf(hi) << 16); }
__device__ __forceinline__ float fexp2(float v) { return __builtin_amdgcn_exp2f(v); }
__device__ __forceinline__ float frcp(float v) { return __builtin_amdgcn_rcpf(v); }
__device__ __forceinline__ float sigm(float v) { return frcp(1.f + fexp2(-LOG2E * v)); }
__device__ __forceinline__ float silu(float v) { return v * sigm(v); }
__device__ __forceinline__ float gelu_t(float v) { const float z = 0.7978845608028654f * (v + 0.044715f * v * v * v); return v * sigm(2.f * z); }
__device__ __forceinline__ float clamp8(float v) { return fminf(fmaxf(v, -448.f), 448.f); }
__device__ __forceinline__ unsigned pk4_fp8(float a, float b, float c, float d) { int p = __builtin_amdgcn_cvt_pk_fp8_f32(clamp8(a), clamp8(b), 0, false); p = __builtin_amdgcn_cvt_pk_fp8_f32(clamp8(c), clamp8(d), p, true); return (unsigned)p; }
constexpr float W8SCALE = 32.f, W8INV = 1.f / 32.f;
__device__ __forceinline__ float wave_sum(float v) {
#pragma unroll
    for (int o = 1; o < 64; o <<= 1) v += __shfl_xor(v, o);
    return v;
}
__device__ __forceinline__ int permsrc(int L) { return 16 * ((L >> 2) & 1) + 4 * (L >> 3) + (L & 3); }
__device__ __forceinline__ int krow_of(int m) { return m < NTOK ? (m >> 13) * KVB + CTX + (m & (SEQ - 1)) : ((m - NTOK) >> 8) * KVB + ((m - NTOK) & (CTX - 1)); }

struct Ctx {
    const float* in[26]; float* out; unsigned char* ws;
    int tid, lane, wave, vcu, G;
    LAS unsigned char* lds;
    __device__ __forceinline__ bf16* b16(size_t off) const { return (bf16*)(ws + off); }
    __device__ __forceinline__ float* f32(size_t off) const { return (float*)(ws + off); }
    __device__ __forceinline__ int* i32(size_t off) const { return (int*)(ws + off); }
};

__device__ __forceinline__ void p0_tr_item(const float* W, int ldw, int k0, int srccol0, bf16* WT, int ldt, bool perm, LAS float* scr, int lane) {
#pragma unroll 8
    for (int i = 0; i < 32; ++i) { const int kk = 2 * i + (lane >> 5); scr[kk * 33 + (lane & 31)] = W[(size_t)(k0 + kk) * ldw + srccol0 + (lane & 31)]; }
    LDS_WAIT(); asm volatile("" ::: "memory");
    const int c = lane & 7;
#pragma unroll
    for (int j = 0; j < 4; ++j) { const int n = (lane >> 3) + 8 * j; const int sg = perm ? permsrc(n) : n; const LAS float* s = scr + (8 * c) * 33 + sg;
        v4u o; o.x = pk2(s[0 * 33], s[1 * 33]); o.y = pk2(s[2 * 33], s[3 * 33]); o.z = pk2(s[4 * 33], s[5 * 33]); o.w = pk2(s[6 * 33], s[7 * 33]);
        *(GAS v4u*)(WT + (size_t)n * ldt + 8 * c) = o; }
    LDS_WAIT(); asm volatile("" ::: "memory");
}
__device__ __forceinline__ void p0_tr_item8(const float* W, int ldw, int k0, int srccol0, unsigned char* WT8, int ldt, bool perm, LAS float* scr, int lane) {
#pragma unroll 8
    for (int i = 0; i < 32; ++i) { const int kk = 2 * i + (lane >> 5); scr[kk * 33 + (lane & 31)] = W[(size_t)(k0 + kk) * ldw + srccol0 + (lane & 31)]; }
    LDS_WAIT(); asm volatile("" ::: "memory");
    const int c = lane & 7;
#pragma unroll
    for (int j = 0; j < 4; ++j) { const int n = (lane >> 3) + 8 * j; const int sg = perm ? permsrc(n) : n; const LAS float* s = scr + (8 * c) * 33 + sg;
        v2u o; o.x = pk4_fp8(s[0 * 33] * W8SCALE, s[1 * 33] * W8SCALE, s[2 * 33] * W8SCALE, s[3 * 33] * W8SCALE); o.y = pk4_fp8(s[4 * 33] * W8SCALE, s[5 * 33] * W8SCALE, s[6 * 33] * W8SCALE, s[7 * 33] * W8SCALE);
        *(GAS v2u*)(WT8 + (size_t)n * ldt + 8 * c) = o; }
    LDS_WAIT(); asm volatile("" ::: "memory");
}
__device__ __forceinline__ void p0_prologue(const Ctx& C) {
    const float* c_in = C.in[1]; const float* cctx = C.in[3]; const float* w_ada = C.in[4]; const float* b_ada = C.in[5];
    {
        LAS float* sc = (LAS float*)C.lds;
        LAS float* part = (LAS float*)(C.lds + 32768);
        for (int i = C.tid; i < 5 * D; i += NTHR) { const int r = i >> 10, k = i & 1023; const float v = r < 4 ? c_in[r * D + k] : cctx[k]; sc[i] = silu(v); }
        __syncthreads();
        for (int n0 = C.vcu * 24; n0 < 6 * D; n0 += C.G * 24) {
            const int col = C.tid % 24, ks = C.tid / 24;
            if (ks < 21) {
                float a0 = 0.f, a1 = 0.f, a2 = 0.f, a3 = 0.f, a4 = 0.f;
#pragma unroll 7
                for (int k = ks; k < D; k += 21) { const float w = w_ada[(size_t)k * 6 * D + n0 + col];
                    a0 += sc[k] * w; a1 += sc[D + k] * w; a2 += sc[2 * D + k] * w; a3 += sc[3 * D + k] * w; a4 += sc[4 * D + k] * w; }
                LAS float* p = part + (ks * 5) * 24 + col; p[0] = a0; p[24] = a1; p[48] = a2; p[72] = a3; p[96] = a4;
            }
            __syncthreads();
            if (C.tid < 120) { const int r = C.tid / 24, cc = C.tid % 24; float s = 0.f;
                for (int q = 0; q < 21; ++q) s += part[(q * 5 + r) * 24 + cc];
                C.f32(WS_MOD)[r * 6 * D + n0 + cc] = s + b_ada[n0 + cc]; }
            __syncthreads();
        }
    }
    LAS float* scr = (LAS float*)(C.lds + C.wave * 16384);
    const int gw = C.vcu * NWAVES + C.wave, NGW = C.G * NWAVES;
    constexpr int I_IN = 16 * 120, I_PAB = 512, I_O = 512, I_13 = NEXP * 512, I_2 = NEXP * 256, NITEMS = I_IN + I_PAB + I_O + I_13 + I_2;
    for (int it = gw; it < NITEMS; it += NGW) {
        int r = it;
        if (r < I_IN) { const int kb = r / 120, nb = r % 120, n0 = 32 * nb; int src = n0; bool perm = n0 < 640;
            if (n0 >= 1792) { const int i = (n0 - 1792) >> 8, within = (n0 - 1792) & 255; src = ((within >> 7) ? 2816 : 1792) + 128 * i + (within & 127); }
            p0_tr_item8(C.in[6], INW, 64 * kb, src, C.ws + WS_WIN + (size_t)n0 * D + 64 * kb, D, perm, scr, C.lane); continue; }
        r -= I_IN;
        if (r < I_PAB) { const int which = r >> 8, rr = r & 255, kb = rr >> 5, nb = rr & 31;
            p0_tr_item(which ? C.in[13] : C.in[12], D, 64 * kb, 32 * nb, C.b16(WS_WPAB) + (size_t)(32 * nb) * D + which * 512 + 64 * kb, D, false, scr, C.lane); continue; }
        r -= I_PAB;
        if (r < I_O) { const int kb = r >> 5, nb = r & 31;
            p0_tr_item(C.in[14], D, 64 * kb, 32 * nb, C.b16(WS_WO) + (size_t)(32 * nb) * D + 64 * kb, D, false, scr, C.lane); continue; }
        r -= I_O;
        if (r < I_13) { const int e = r >> 9, rr = r & 511, which = rr >> 8, r2 = rr & 255, kb = r2 >> 4, cb = r2 & 15;
            const int jb = (32 * cb) >> 7, c0 = (32 * cb) & 127, prow = 256 * jb + 128 * which + c0;
            p0_tr_item8((which ? C.in[22] : C.in[21]) + (size_t)e * D * DEXP, DEXP, 64 * kb, 32 * cb, C.ws + WS_W13 + ((size_t)e * 1024 + prow) * D + 64 * kb, D, false, scr, C.lane); continue; }
        r -= I_13;
        { const int e = r >> 8, rr = r & 255, kb = rr >> 5, nb = rr & 31;
            p0_tr_item8(C.in[23] + (size_t)e * DEXP * D, D, 64 * kb, 32 * nb, C.ws + WS_W2 + ((size_t)e * 1024 + 32 * nb) * DEXP + 64 * kb, DEXP, false, scr, C.lane); }
    }
    const int gt = C.vcu * NTHR + C.tid, NGT = C.G * NTHR;
    for (int i = gt; i < XG_ROWS; i += NGT) C.i32(WS_TOKSLOT)[i] = -1;
    for (int i = gt; i < 8 * 128 * 128; i += NGT) {
        const int kp = i & 127, s = kp >> 4, h = (kp >> 3) & 1, j = kp & 7, q = 16 * s + 8 * (j >> 2) + 4 * h + (j & 3);
        C.b16(WS_WSGM)[i] = (bf16)f2bf(C.in[10][(i & ~127) + q]); }
    for (int i = gt; i < 48 * D; i += NGT) {
        const int e = i >> 10, k = i & 1023; float v = 0.f;
        if (e < 4) v = C.in[17][k * 4 + e]; else if (e < 36) { const int g = (e - 4) >> 3, ee = (e - 4) & 7; v = C.in[19][((size_t)g * D + k) * 8 + ee]; }
        C.b16(WS_RT)[i] = (bf16)f2bf(v); }
    for (int i = gt; i < 128 * 16; i += NGT) {
        const int pos = i >> 4, f = i & 15;
        const float inv = exp2f(-(float)f * 0.83048202372184f); const float angf = (float)pos * inv;
        const double twopi = 6.283185307179586476925; double r = (double)angf / twopi; r -= __builtin_rint(r); const double x = r * twopi, x2 = x * x;
        double s = 1.0, cs = 1.0, sterm = 1.0, cterm = 1.0;
        for (int n = 1; n <= 14; ++n) { cterm *= -x2 / (double)((2 * n - 1) * (2 * n)); sterm *= -x2 / (double)((2 * n) * (2 * n + 1)); cs += cterm; s += sterm; }
        C.f32(WS_TAB)[2 * i] = (float)cs; C.f32(WS_TAB)[2 * i + 1] = (float)(s * x); }
}

__device__ __forceinline__ void ln_mod_row8(const float* xrow, const float* sh, const float* sc, unsigned char* orow, int lane) {
    const GAS f32x4* xr = (const GAS f32x4*)xrow + lane;
    f32x4 v[4]; float s = 0.f;
#pragma unroll
    for (int j = 0; j < 4; ++j) { v[j] = xr[64 * j]; s += (v[j].x + v[j].y) + (v[j].z + v[j].w); }
    const float mean = wave_sum(s) * (1.f / D); float s2 = 0.f;
#pragma unroll
    for (int j = 0; j < 4; ++j) { v[j] = v[j] - mean; s2 += (v[j].x * v[j].x + v[j].y * v[j].y) + (v[j].z * v[j].z + v[j].w * v[j].w); }
    const float rstd = 1.f / sqrtf(wave_sum(s2) * (1.f / D) + LN_EPS);
    GAS unsigned* o4 = (GAS unsigned*)orow + lane;
#pragma unroll
    for (int j = 0; j < 4; ++j) { const f32x4 a = *((const GAS f32x4*)sc + lane + 64 * j), b = *((const GAS f32x4*)sh + lane + 64 * j);
        const f32x4 o = v[j] * rstd * (a + 1.f) + b; o4[64 * j] = pk4_fp8(o.x, o.y, o.z, o.w); }
}
__device__ __forceinline__ void p1_ln(const Ctx& C) {
    const int gw = C.vcu * NWAVES + C.wave, NGW = C.G * NWAVES; const float* mod = C.f32(WS_MOD);
    for (int m = gw; m < HROWS; m += NGW) {
        const float* src = m < NTOK ? C.in[0] + (size_t)m * D : C.in[2] + (size_t)(m - NTOK) * D;
        const float* md = mod + (m < NTOK ? (m >> 13) : 4) * 6 * D;
        ln_mod_row8(src, md, md + D, C.ws + WS_H8 + (size_t)m * D, C.lane);
    }
}

__device__ __forceinline__ void p7_gather(const Ctx& C) {
    const int* cnt = (const int*)(C.ws + WS_CTL) + CW_CNT;
    LAS int* part = (LAS int*)C.lds;
    LAS int* tot = part + 512;
    LAS int* base = tot + 32;
    LAS int* off = base + 32;
    LAS int* le = off + 32;
    LAS int* lpos = le + 256;
    { const int e = C.tid & 31, pt = C.tid >> 5; int s = 0; for (int q = 0; q < 16; ++q) s += __hip_atomic_load(cnt + (pt * 16 + q) * 32 + e, __ATOMIC_RELAXED, __HIP_MEMORY_SCOPE_AGENT); part[pt * 32 + e] = s; }
    __syncthreads();
    if (C.tid < 32) { int s = 0; for (int q = 0; q < 16; ++q) s += part[q * 32 + C.tid]; tot[C.tid] = s; }
    __syncthreads();
    if (C.tid == 0) { int b = 0; for (int e = 0; e < 32; ++e) { base[e] = b; b += (tot[e] + 255) & ~255; }
        if (C.vcu == 0) { int* tl = C.i32(WS_TILE); int nt = 0; for (int e = 0; e < 32; ++e) { const int k = (tot[e] + 255) >> 8; for (int q = 0; q < k; ++q) tl[1 + nt + q] = e; nt += k; } tl[0] = nt; } }
    __syncthreads();
    for (int slot = C.vcu; slot < NTOK / 128; slot += C.G) {
        if (C.tid < 32) { int s = base[C.tid]; for (int q = 0; q < slot; ++q) s += __hip_atomic_load(cnt + q * 32 + C.tid, __ATOMIC_RELAXED, __HIP_MEMORY_SCOPE_AGENT); off[C.tid] = s; }
        if (C.tid < 256) le[C.tid] = C.i32(WS_EIDX)[slot * 256 + C.tid];
        __syncthreads();
        if (C.tid < 256) { const int e = le[C.tid]; int r = 0; for (int q = 0; q < C.tid; ++q) r += (le[q] == e) ? 1 : 0; const int pos = off[e] + r; lpos[C.tid] = pos;
            C.i32(WS_TOKSLOT)[pos] = slot * 256 + C.tid; C.f32(WS_WTL)[pos] = C.f32(WS_EWT)[slot * 256 + C.tid]; }
        __syncthreads();
        for (int i0 = C.wave * 32; i0 < C.wave * 32 + 32; i0 += 16) {
            v4u ra[16];
#pragma unroll
            for (int q = 0; q < 16; ++q) { const int i = i0 + q, m = slot * 128 + (i >> 1); ra[q] = ((const GAS v4u*)(C.ws + WS_H8 + (size_t)m * D))[C.lane]; }
#pragma unroll
            for (int q = 0; q < 16; ++q) ((GAS v4u*)(C.ws + WS_XG + (size_t)lpos[i0 + q] * D))[C.lane] = ra[q];
        }
        __syncthreads();
    }
}
__device__ __forceinline__ void p10_final(const Ctx& C) {
    const int gw = C.vcu * NWAVES + C.wave, NGW = C.G * NWAVES; const float* mod = C.f32(WS_MOD); const float* g = C.in[24]; const float* bb = C.in[25];
#pragma unroll 2
    for (int m = gw; m < NTOK; m += NGW) {
        GAS f32x4* xr = (GAS f32x4*)(C.out + (size_t)m * D) + C.lane; const float* g2 = mod + (m >> 13) * 6 * D + 5 * D;
        const GAS v2u* x1 = (const GAS v2u*)(C.b16(WS_X1B) + (size_t)m * D) + C.lane;
        const GAS v2u* y0 = (const GAS v2u*)(C.b16(WS_YSLOT) + (size_t)(2 * m) * D) + C.lane; const GAS v2u* y1 = (const GAS v2u*)(C.b16(WS_YSLOT) + (size_t)(2 * m + 1) * D) + C.lane;
        f32x4 v[4]; float s = 0.f;
#pragma unroll
        for (int j = 0; j < 4; ++j) { const v2u xx = x1[64 * j]; const v2u a = y0[64 * j], b = y1[64 * j]; const f32x4 gg = *((const GAS f32x4*)g2 + C.lane + 64 * j);
            f32x4 y; y.x = bflo(a.x) + bflo(b.x); y.y = bfhi(a.x) + bfhi(b.x); y.z = bflo(a.y) + bflo(b.y); y.w = bfhi(a.y) + bfhi(b.y);
            f32x4 xv; xv.x = bflo(xx.x); xv.y = bfhi(xx.x); xv.z = bflo(xx.y); xv.w = bfhi(xx.y);
            v[j] = xv * ALPHA + gg * y; s += (v[j].x + v[j].y) + (v[j].z + v[j].w); }
        const float mean = wave_sum(s) * (1.f / D); float s2 = 0.f;
#pragma unroll
        for (int j = 0; j < 4; ++j) { v[j] = v[j] - mean; s2 += (v[j].x * v[j].x + v[j].y * v[j].y) + (v[j].z * v[j].z + v[j].w * v[j].w); }
        const float rstd = 1.f / sqrtf(wave_sum(s2) * (1.f / D) + LN_EPS);
#pragma unroll
        for (int j = 0; j < 4; ++j) { const f32x4 a = *((const GAS f32x4*)g + C.lane + 64 * j), b = *((const GAS f32x4*)bb + C.lane + 64 * j); xr[64 * j] = v[j] * rstd * a + b; }
    }
}

typedef pg8::Unit Unit;
__device__ __forceinline__ v4u pack8(const f32x4 a, const f32x4 b) { v4u w; w.x = pg8::cvt_pk_bf16(a[0], a[1]); w.y = pg8::cvt_pk_bf16(a[2], a[3]); w.z = pg8::cvt_pk_bf16(b[0], b[1]); w.w = pg8::cvt_pk_bf16(b[2], b[3]); return w; }
__device__ __forceinline__ void unpack8(const v4u w, f32x4& a, f32x4& b) { a[0] = bflo(w.x); a[1] = bfhi(w.x); a[2] = bflo(w.y); a[3] = bfhi(w.y); b[0] = bflo(w.z); b[1] = bfhi(w.z); b[2] = bflo(w.w); b[3] = bfhi(w.w); }

struct InProjOrder {
    pg8::StaticOrder so;
    __device__ __forceinline__ void init(int G, int c) { so.init(NTOK, INW, G, c); }
    __device__ __forceinline__ bool next(int i, Unit& u) const {
        if (so.next(i, u)) return true;
        const long L = (long)i * so.G + so.c - so.nwg; if (L < 0 || L >= 4) return false;
        u.pm = NTOK / 256 + (int)L; u.pn = 2; u.pb = 2; return true;
    }
    __device__ __forceinline__ void a_ready(const Unit&) const {}
    __device__ __forceinline__ void done(const Unit&) const {}
};
struct EpiInProj {
    static constexpr bool PERM = true, AFTER_DRAIN = false; static constexpr int MID_T = 0;
    bf16 *Q, *K, *V, *U, *VG, *GR, *GS; const float* tab; float osc;
    __device__ __forceinline__ void operator()(const f32x4 (&acc)[2][2][4][2], const Unit& u, int wr, int wc, int fr, int fq) const {
        const int rowb = u.pm * 256 + wr * 64 + fr, cw = wc * 32 + 8 * fq;
        if (u.pn <= 2) {
            const bool isctx = u.pm >= NTOK / 256;
#pragma unroll
            for (int ai = 0; ai < 2; ++ai)
#pragma unroll
                for (int m = 0; m < 4; ++m) {
                    const int row = rowb + ai * 128 + m * 16, t = row & (SEQ - 1), pos = (wc & 1) ? (t & 63) : (t >> 6);
                    f32x4 t0 = (f32x4){1.f, 0.f, 1.f, 0.f}, t1 = t0;
                    if (!isctx) { const GAS f32x4* tp = (const GAS f32x4*)(tab + 2 * (pos * 16 + 4 * fq)); t0 = tp[0]; t1 = tp[1]; }
                    const f32x4 cs = (f32x4){t0[0], t0[2], t1[0], t1[2]}, sn = (f32x4){t0[1], t0[3], t1[1], t1[3]};
                    const int kr = krow_of(row);
#pragma unroll
                    for (int bj = 0; bj < 2; ++bj) {
                        const f32x4 xa = acc[ai][bj][m][0] * osc, xb = acc[ai][bj][m][1] * osc;
                        if (u.pn == 2 && bj == 1) { *(GAS v4u*)(V + (size_t)kr * 128 + cw) = pack8(xa, xb); }
                        else {
                            f32x4 oa = xa * cs - xb * sn, ob = xb * cs + xa * sn;
                            if (u.pn < 2) { oa = oa * QSCALE; ob = ob * QSCALE; *(GAS v4u*)(Q + (size_t)row * 512 + u.pn * 256 + bj * 128 + cw) = pack8(oa, ob); }
                            else *(GAS v4u*)(K + (size_t)kr * 128 + cw) = pack8(oa, ob);
                        }
                    }
                }
        } else if (u.pn <= 6) {
            bf16* dst = (u.pn < 5 ? U : VG) + ((u.pn - 3) & 1) * 256 + cw;
#pragma unroll
            for (int ai = 0; ai < 2; ++ai)
#pragma unroll
                for (int m = 0; m < 4; ++m) { const int row = rowb + ai * 128 + m * 16;
#pragma unroll
                    for (int bj = 0; bj < 2; ++bj) { f32x4 a = acc[ai][bj][m][0] * osc, b = acc[ai][bj][m][1] * osc;
#pragma unroll
                        for (int j = 0; j < 4; ++j) { a[j] = gelu_t(a[j]); b[j] = gelu_t(b[j]); }
                        *(GAS v4u*)(dst + (size_t)row * 512 + bj * 128) = pack8(a, b); } }
        } else {
            const int col = 128 * (u.pn - 7) + cw;
#pragma unroll
            for (int ai = 0; ai < 2; ++ai)
#pragma unroll
                for (int m = 0; m < 4; ++m) { const int row = rowb + ai * 128 + m * 16; f32x4 r[2], s[2];
#pragma unroll
                    for (int n = 0; n < 2; ++n)
#pragma unroll
                        for (int j = 0; j < 4; ++j) { const float ea = fexp2(-LOG2E * osc * acc[ai][0][m][n][j]), eb = fexp2(-LOG2E * osc * acc[ai][1][m][n][j]); const float sb = frcp(1.f + eb); s[n][j] = sb; r[n][j] = (1.f + eb) * frcp(1.f + ea); }
                    *(GAS v4u*)(GR + (size_t)row * D + col) = pack8(r[0], r[1]); *(GAS v4u*)(GS + (size_t)row * D + col) = pack8(s[0], s[1]); }
        }
    }
};
__device__ __forceinline__ void p2_inproj(const Ctx& C) {
    pg8::Gemm g{(const bf16*)(C.ws + WS_H8), (const bf16*)(C.ws + WS_WIN), HROWS, INW, D};
    InProjOrder S; S.init(C.G, (int)blockIdx.x);
    EpiInProj E{C.b16(WS_Q), C.b16(WS_K), C.b16(WS_V), C.b16(WS_U), C.b16(WS_VG), C.b16(WS_GR), C.b16(WS_GS), C.f32(WS_TAB), W8INV};
    pg8::gemm_phase8<EpiInProj, InProjOrder, true, true>((PG8_LAS unsigned char*)C.lds, g, S, E);
}

struct EpiMerge {
    static constexpr bool PERM = true, AFTER_DRAIN = false; static constexpr int MID_T = 8;
    const bf16 *GR, *GS; bf16* Y;
    __device__ __forceinline__ void mid(f32x4 (&acc)[2][2][4][2], const Unit& u, int wr, int wc, int fr, int fq) const {
        int rowb = u.pm * 256 + wr * 64 + fr, col = u.pn * 256 + wc * 32 + 8 * fq;
        asm volatile("" : "+v"(rowb), "+v"(col));
        v4u w[2][4][2];
#pragma unroll
        for (int ai = 0; ai < 2; ++ai)
#pragma unroll
            for (int m = 0; m < 4; ++m)
#pragma unroll
                for (int bj = 0; bj < 2; ++bj) w[ai][m][bj] = *(const GAS v4u*)(GR + (size_t)(rowb + ai * 128 + m * 16) * D + col + bj * 128);
#pragma unroll
        for (int ai = 0; ai < 2; ++ai)
#pragma unroll
            for (int m = 0; m < 4; ++m)
#pragma unroll
                for (int bj = 0; bj < 2; ++bj) { f32x4 a, b; unpack8(w[ai][m][bj], a, b); acc[ai][bj][m][0] *= a; acc[ai][bj][m][1] *= b; }
    }
    __device__ __forceinline__ void operator()(const f32x4 (&acc)[2][2][4][2], const Unit& u, int wr, int wc, int fr, int fq) const {
        const int rowb = u.pm * 256 + wr * 64 + fr, col = u.pn * 256 + wc * 32 + 8 * fq;
#pragma unroll
        for (int ai = 0; ai < 2; ++ai)
#pragma unroll
            for (int m = 0; m < 4; ++m)
#pragma unroll
                for (int bj = 0; bj < 2; ++bj) { const size_t off = (size_t)(rowb + ai * 128 + m * 16) * D + col + bj * 128; const v4u w = *(const GAS v4u*)(GS + off); f32x4 a, b; unpack8(w, a, b);
                    *(GAS v4u*)(Y + off) = pack8(acc[ai][bj][m][0] * a, acc[ai][bj][m][1] * b); if (bj) asm volatile("" ::: "memory"); }
    }
};
__device__ __forceinline__ void p4_merge(const Ctx& C) {
    pg8::Gemm g{C.b16(WS_YCAT), C.b16(WS_WPAB), NTOK, D, D};
    pg8::StaticOrder S; S.init(NTOK, D, C.G, (int)blockIdx.x);
    EpiMerge E{C.b16(WS_GR), C.b16(WS_GS), C.b16(WS_Y)};
    pg8::gemm_phase<EpiMerge, pg8::StaticOrder, true, true>((PG8_LAS unsigned char*)C.lds, g, S, E);
}

struct MoeOrder {
    const int* tl; int G, c;
    __device__ __forceinline__ bool next(int i, Unit& u) const {
        const int L = i * G + c, nt = tl[0]; if (L >= nt * 4) return false;
        u.pm = L >> 2; u.pn = L & 3; u.pb = tl[1 + (L >> 2)] * 4 + (L & 3); return true;
    }
    __device__ __forceinline__ void a_ready(const Unit&) const {}
    __device__ __forceinline__ void done(const Unit&) const {}
};
struct EpiGateUp {
    static constexpr bool PERM = true, AFTER_DRAIN = false; static constexpr int MID_T = 0;
    unsigned char* HID;
    __device__ __forceinline__ void operator()(const f32x4 (&acc)[2][2][4][2], const Unit& u, int wr, int wc, int fr, int fq) const {
        const int rowb = u.pm * 256 + wr * 64 + fr, col = u.pn * 128 + wc * 32 + 8 * fq;
#pragma unroll
        for (int ai = 0; ai < 2; ++ai)
#pragma unroll
            for (int m = 0; m < 4; ++m) { f32x4 h[2];
#pragma unroll
                for (int n = 0; n < 2; ++n)
#pragma unroll
                    for (int j = 0; j < 4; ++j) h[n][j] = silu(acc[ai][0][m][n][j] * W8INV) * (acc[ai][1][m][n][j] * W8INV);
                v2u w; w.x = pk4_fp8(h[0][0], h[0][1], h[0][2], h[0][3]); w.y = pk4_fp8(h[1][0], h[1][1], h[1][2], h[1][3]);
                *(GAS v2u*)(HID + (size_t)(rowb + ai * 128 + m * 16) * DEXP + col) = w; }
    }
};
struct EpiDown {
    static constexpr bool PERM = true, AFTER_DRAIN = false; static constexpr int MID_T = 0;
    const int* ts; const float* wt; bf16* YS;
    __device__ __forceinline__ void operator()(const f32x4 (&acc)[2][2][4][2], const Unit& u, int wr, int wc, int fr, int fq) const {
        const int rowb = u.pm * 256 + wr * 64 + fr, col = u.pn * 256 + wc * 32 + 8 * fq;
#pragma unroll
        for (int ai = 0; ai < 2; ++ai)
#pragma unroll
            for (int m = 0; m < 4; ++m) { const int row = rowb + ai * 128 + m * 16; const int slot = ts[row]; const float w = wt[row] * W8INV;
                if (slot >= 0) {
#pragma unroll
                    for (int bj = 0; bj < 2; ++bj) *(GAS v4u*)(YS + (size_t)slot * D + col + bj * 128) = pack8(acc[ai][bj][m][0] * w, acc[ai][bj][m][1] * w); } }
    }
};
__device__ __forceinline__ void p8_gateup(const Ctx& C) {
    pg8::Gemm g{(const bf16*)(C.ws + WS_XG), (const bf16*)(C.ws + WS_W13), XG_ROWS, 1024, D};
    MoeOrder S{C.i32(WS_TILE), C.G, C.vcu};
    EpiGateUp E{C.ws + WS_HID};
    pg8::gemm_phase8<EpiGateUp, MoeOrder, true, true>((PG8_LAS unsigned char*)C.lds, g, S, E);
}
__device__ __forceinline__ void p9_down(const Ctx& C) {
    pg8::Gemm g{(const bf16*)(C.ws + WS_HID), (const bf16*)(C.ws + WS_W2), XG_ROWS, 1024, DEXP};
    MoeOrder S{C.i32(WS_TILE), C.G, C.vcu};
    EpiDown E{C.i32(WS_TOKSLOT), C.f32(WS_WTL), C.b16(WS_YSLOT)};
    pg8::gemm_phase8<EpiDown, MoeOrder, true, true>((PG8_LAS unsigned char*)C.lds, g, S, E);
}

struct EpiWoPre {
    static constexpr bool PERM = true, AFTER_DRAIN = false; static constexpr int MID_T = 0;
    const float* x; const float* mod; bf16* V1;
    __device__ __forceinline__ void operator()(const f32x4 (&acc)[2][2][4][2], const Unit& u, int wr, int wc, int fr, int fq) const {
        const int rowb = u.pm * 256 + wr * 64 + fr, col = u.pn * 256 + wc * 32 + 8 * fq;
        const float* g1 = mod + ((u.pm * 256) >> 13) * 6 * D + 2 * D + col;
        f32x4 gv[2][2];
#pragma unroll
        for (int bj = 0; bj < 2; ++bj) { gv[bj][0] = *(const GAS f32x4*)(g1 + bj * 128); gv[bj][1] = *(const GAS f32x4*)(g1 + bj * 128 + 4); }
#pragma unroll
        for (int ai = 0; ai < 2; ++ai) {
            f32x4 xs[4][2][2];
#pragma unroll
            for (int m = 0; m < 4; ++m)
#pragma unroll
                for (int bj = 0; bj < 2; ++bj) { const float* xp = x + (size_t)(rowb + ai * 128 + m * 16) * D + col + bj * 128; xs[m][bj][0] = *(const GAS f32x4*)xp; xs[m][bj][1] = *(const GAS f32x4*)(xp + 4); }
#pragma unroll
            for (int m = 0; m < 4; ++m)
#pragma unroll
                for (int bj = 0; bj < 2; ++bj)
                    *(GAS v4u*)(V1 + (size_t)(rowb + ai * 128 + m * 16) * D + col + bj * 128) = pack8(xs[m][bj][0] * ALPHA + gv[bj][0] * acc[ai][bj][m][0], xs[m][bj][1] * ALPHA + gv[bj][1] * acc[ai][bj][m][1]);
            asm volatile("" ::: "memory");
        }
    }
};
__device__ __forceinline__ void p5_wo(const Ctx& C) {
    pg8::Gemm g{C.b16(WS_Y), C.b16(WS_WO), NTOK, D, D};
    pg8::StaticOrder S; S.init(NTOK, D, C.G, (int)blockIdx.x);
    EpiWoPre E{C.in[0], C.f32(WS_MOD), C.b16(WS_V1)};
    pg8::gemm_phase<EpiWoPre, pg8::StaticOrder, true, true>((PG8_LAS unsigned char*)C.lds, g, S, E);
}

typedef short bf16x8 __attribute__((ext_vector_type(8)));
typedef short s16x4 __attribute__((ext_vector_type(4)));
typedef float f32x16 __attribute__((ext_vector_type(16)));
__device__ __forceinline__ float sum8(const f32x4 a, const f32x4 b) { return ((a[0] + a[1]) + (a[2] + a[3])) + ((b[0] + b[1]) + (b[2] + b[3])); }
__device__ __forceinline__ float sq8(const f32x4 a, const f32x4 b) { return ((a[0] * a[0] + a[1] * a[1]) + (a[2] * a[2] + a[3] * a[3])) + ((b[0] * b[0] + b[1] * b[1]) + (b[2] * b[2] + b[3] * b[3])); }
__device__ __forceinline__ void p5b_rows(const Ctx& C) {
    const bf16* V1 = C.b16(WS_V1); bf16* X1B = C.b16(WS_X1B); bf16* H = C.b16(WS_H); const bf16* RT = C.b16(WS_RT); const float* bg = C.in[18]; const float* be = C.in[20];
    constexpr int RTP = 2064;
    LAS unsigned char* rtl = C.lds;
    LAS float* lg = (LAS float*)(C.lds + 100352 + C.wave * 3200);
    __syncthreads();
    for (int i = C.tid; i < 48 * 128; i += NTHR) { const int e = i >> 7, c = i & 127; *(LAS v4u*)(rtl + e * RTP + c * 16) = *(const GAS v4u*)(RT + (size_t)e * D + c * 8); }
    LDS_WAIT(); __syncthreads();
    const int gw = C.vcu * NWAVES + C.wave, NGW = C.G * NWAVES, lane = C.lane, fr = lane & 15, fq = lane >> 4;
    for (int t0 = gw * 16; t0 < NTOK; t0 += NGW * 16) {
        const float* md = C.f32(WS_MOD) + (t0 >> 13) * 6 * D;
        f32x4 lg1[2][2], lb1[2][2], sc2[2][2], sh2[2][2];
#pragma unroll
        for (int hf = 0; hf < 2; ++hf)
#pragma unroll
            for (int q = 0; q < 2; ++q) { const int c = 512 * hf + 8 * lane + 4 * q;
                lg1[hf][q] = *(const GAS f32x4*)(C.in[15] + c); lb1[hf][q] = *(const GAS f32x4*)(C.in[16] + c); sc2[hf][q] = *(const GAS f32x4*)(md + 4 * D + c) + 1.f; sh2[hf][q] = *(const GAS f32x4*)(md + 3 * D + c); }
#pragma unroll 2
        for (int r = 0; r < 16; ++r) {
            const size_t ro = (size_t)(t0 + r) * D + 8 * lane;
            const v4u w0 = *(const GAS v4u*)(V1 + ro), w1 = *(const GAS v4u*)(V1 + ro + 512);
            f32x4 a[2][2]; unpack8(w0, a[0][0], a[0][1]); unpack8(w1, a[1][0], a[1][1]);
            const float mean = wave_sum(sum8(a[0][0], a[0][1]) + sum8(a[1][0], a[1][1])) * (1.f / D);
#pragma unroll
            for (int hf = 0; hf < 2; ++hf) { a[hf][0] = a[hf][0] - mean; a[hf][1] = a[hf][1] - mean; }
            const float rstd = 1.f / sqrtf(wave_sum(sq8(a[0][0], a[0][1]) + sq8(a[1][0], a[1][1])) * (1.f / D) + LN_EPS);
#pragma unroll
            for (int hf = 0; hf < 2; ++hf) { a[hf][0] = a[hf][0] * rstd * lg1[hf][0] + lb1[hf][0]; a[hf][1] = a[hf][1] * rstd * lg1[hf][1] + lb1[hf][1]; }
            *(GAS v4u*)(X1B + ro) = pack8(a[0][0], a[0][1]); *(GAS v4u*)(X1B + ro + 512) = pack8(a[1][0], a[1][1]);
            const float mean2 = wave_sum(sum8(a[0][0], a[0][1]) + sum8(a[1][0], a[1][1])) * (1.f / D);
#pragma unroll
            for (int hf = 0; hf < 2; ++hf) { a[hf][0] = a[hf][0] - mean2; a[hf][1] = a[hf][1] - mean2; }
            const float rstd2 = 1.f / sqrtf(wave_sum(sq8(a[0][0], a[0][1]) + sq8(a[1][0], a[1][1])) * (1.f / D) + LN_EPS);
#pragma unroll
            for (int hf = 0; hf < 2; ++hf) { a[hf][0] = a[hf][0] * rstd2 * sc2[hf][0] + sh2[hf][0]; a[hf][1] = a[hf][1] * rstd2 * sc2[hf][1] + sh2[hf][1]; }
            *(GAS v4u*)(H + ro) = pack8(a[0][0], a[0][1]); *(GAS v4u*)(H + ro + 512) = pack8(a[1][0], a[1][1]);
            { GAS unsigned char* h8 = (GAS unsigned char*)(C.ws + WS_H8) + ro; v2u e0, e1; e0.x = pk4_fp8(a[0][0][0], a[0][0][1], a[0][0][2], a[0][0][3]); e0.y = pk4_fp8(a[0][1][0], a[0][1][1], a[0][1][2], a[0][1][3]);
              e1.x = pk4_fp8(a[1][0][0], a[1][0][1], a[1][0][2], a[1][0][3]); e1.y = pk4_fp8(a[1][1][0], a[1][1][1], a[1][1][2], a[1][1][3]); *(GAS v2u*)h8 = e0; *(GAS v2u*)(h8 + 512) = e1; }
        }
        asm volatile("s_waitcnt vmcnt(0)" ::: "memory");
        f32x4 a0 = (f32x4){0.f, 0.f, 0.f, 0.f}, a1 = a0, a2 = a0;
        const bf16* hr = H + (size_t)(t0 + fr) * D + 8 * fq; const LAS unsigned char* rr = rtl + fr * RTP + 16 * fq;
        bf16x8 av[32];
#pragma unroll
        for (int s = 0; s < 32; ++s) av[s] = __builtin_nontemporal_load((const GAS bf16x8*)(hr + 32 * s));
#pragma unroll
        for (int s = 0; s < 32; ++s) {
            const bf16x8 b0 = *(const LAS bf16x8*)(rr + 64 * s), b1 = *(const LAS bf16x8*)(rr + 16 * RTP + 64 * s), b2 = *(const LAS bf16x8*)(rr + 32 * RTP + 64 * s);
            a0 = __builtin_amdgcn_mfma_f32_16x16x32_bf16(av[s], b0, a0, 0, 0, 0); a1 = __builtin_amdgcn_mfma_f32_16x16x32_bf16(av[s], b1, a1, 0, 0, 0); a2 = __builtin_amdgcn_mfma_f32_16x16x32_bf16(av[s], b2, a2, 0, 0, 0);
        }
#pragma unroll
        for (int r = 0; r < 4; ++r) { lg[(4 * fq + r) * 49 + fr] = a0[r]; lg[(4 * fq + r) * 49 + 16 + fr] = a1[r]; lg[(4 * fq + r) * 49 + 32 + fr] = a2[r]; }
        LDS_WAIT(); asm volatile("" ::: "memory");
        if (lane < 16) {
            const LAS float* v = lg + lane * 49; const int m = t0 + lane;
            float g4[4];
#pragma unroll
            for (int j = 0; j < 4; ++j) g4[j] = v[j] + bg[j];
            int gi = 0; float gm = g4[0];
#pragma unroll
            for (int j = 1; j < 4; ++j) if (g4[j] > gm) { gm = g4[j]; gi = j; }
            float gs = 0.f;
#pragma unroll
            for (int j = 0; j < 4; ++j) gs += fexp2((g4[j] - gm) * LOG2E);
            const float gwt = 1.f / gs;
            float v8[8];
#pragma unroll
            for (int e = 0; e < 8; ++e) v8[e] = v[4 + gi * 8 + e] + be[gi * 8 + e];
            int i1 = 0; float m1 = v8[0];
#pragma unroll
            for (int e = 1; e < 8; ++e) if (v8[e] > m1) { m1 = v8[e]; i1 = e; }
            int i2 = 0; float m2 = -3.0e38f;
#pragma unroll
            for (int e = 0; e < 8; ++e) if (e != i1 && v8[e] > m2) { m2 = v8[e]; i2 = e; }
            const float e2 = fexp2((m2 - m1) * LOG2E), w1 = 1.f / (1.f + e2), w2 = e2 / (1.f + e2);
            const int ea = gi * 8 + i1, eb = gi * 8 + i2;
            C.i32(WS_EIDX)[2 * m] = ea; C.i32(WS_EIDX)[2 * m + 1] = eb; C.f32(WS_EWT)[2 * m] = gwt * w1; C.f32(WS_EWT)[2 * m + 1] = gwt * w2;
            int* cnt = (int*)(C.ws + WS_CTL) + CW_CNT + (m >> 7) * 32;
            atomicAdd(cnt + ea, 1); atomicAdd(cnt + eb, 1);
        }
        LDS_WAIT(); asm volatile("" ::: "memory");
    }
}

typedef short v4i16_t __attribute__((ext_vector_type(4)));
__device__ __forceinline__ s16x4 vtr(const LAS unsigned char* p) { return __builtin_bit_cast(s16x4, __builtin_amdgcn_ds_read_tr16_b64_v4i16((LAS v4i16_t*)p)); }
__device__ __forceinline__ int crow(int r, int hi) { return (r & 3) + 8 * (r >> 2) + 4 * hi; }
__device__ __forceinline__ float xhalf_max(float v) { auto rr = __builtin_amdgcn_permlane32_swap(__float_as_uint(v), __float_as_uint(v), false, false); return fmaxf(__uint_as_float(rr[0]), __uint_as_float(rr[1])); }
__device__ __forceinline__ float xhalf_sum(float v) { auto rr = __builtin_amdgcn_permlane32_swap(__float_as_uint(v), __float_as_uint(v), false, false); return __uint_as_float(rr[0]) + __uint_as_float(rr[1]); }
#define MK_VFRAG(vp, off) ({ const s16x4 lo_ = vtr((vp) + (off)), hi_ = vtr((vp) + (off) + 512); (bf16x8){lo_[0], lo_[1], lo_[2], lo_[3], hi_[0], hi_[1], hi_[2], hi_[3]}; })

__device__ __forceinline__ void p3_attn(const Ctx& C) {
    const int lane = C.lane, r32 = lane & 31, hi = lane >> 5, w = C.wave;
    LAS unsigned char* Kb = C.lds; LAS unsigned char* Vb = C.lds + 16384;
    const bf16* Q = C.b16(WS_Q); const bf16* Kg = C.b16(WS_K); const bf16* Vg = C.b16(WS_V); bf16* Y = C.b16(WS_YCAT);
    const int upw = (1024 + C.G - 1) / C.G;
    for (int ui = 0; ui < upw; ++ui) {
        const int u = C.vcu * upw + ui; if (u >= 1024) break;
        const int qb = u & 127, hk = (u >> 7) & 1, b = u >> 8, q0 = qb * 64, h = hk * 4 + (w >> 1), qrel = 32 * (w & 1) + r32;
        const size_t qrow = (size_t)b * SEQ + q0 + qrel;
        bf16x8 qr[4];
#pragma unroll
        for (int d0 = 0; d0 < 4; ++d0) qr[d0] = *(const GAS bf16x8*)(Q + qrow * 512 + h * 64 + 16 * d0 + 8 * hi);
        const int jlo = q0 == 0 ? 2 : (q0 == 64 ? 1 : 0), jhi = q0 == SEQ - 64 ? 2 : (q0 == SEQ - 128 ? 3 : 4), nt = 4 + (jhi - jlo + 1);
        float mx = C.in[7][h] * LOG2E, l = hi ? 0.f : 1.f;
        f32x16 o0, o1;
#pragma unroll
        for (int r = 0; r < 16; ++r) { o0[r] = 0.f; o1[r] = 0.f; }
        const int kvrow0 = b * KVB;
#define MK_TROW(ti) ((ti) < 4 ? kvrow0 + 64 * (ti) : kvrow0 + CTX + q0 - 128 + 64 * (jlo + (ti) - 4))
#define MK_STAGE(ti, buf) do { const int row0_ = MK_TROW(ti); \
        __builtin_amdgcn_global_load_lds((const unsigned*)(Kg + (size_t)(row0_ + lane) * 128 + hk * 64 + 8 * w), (LAS unsigned*)(Kb + (buf) * 8192 + w * 1024), 16, 0, 0); \
        __builtin_amdgcn_global_load_lds((const unsigned*)(Vg + (size_t)(row0_ + 16 * (w & 3) + (lane >> 2)) * 128 + hk * 64 + 32 * (w >> 2) + 8 * (lane & 3)), (LAS unsigned*)(Vb + (buf) * 8192 + w * 1024), 16, 0, 0); } while (0)
        MK_STAGE(0, 0);
        for (int ti = 0; ti < nt; ++ti) {
            const int cur = ti & 1;
            __syncthreads();
            if (ti + 1 < nt) MK_STAGE(ti + 1, cur ^ 1);
            const LAS unsigned char* kb = Kb + cur * 8192 + hi * 1024 + r32 * 16;
            f32x16 p0, p1;
#pragma unroll
            for (int r = 0; r < 16; ++r) { p0[r] = 0.f; p1[r] = 0.f; }
#pragma unroll
            for (int d0 = 0; d0 < 4; ++d0) { const bf16x8 k0 = *(const LAS bf16x8*)(kb + d0 * 2048), k1 = *(const LAS bf16x8*)(kb + d0 * 2048 + 512);
                p0 = __builtin_amdgcn_mfma_f32_32x32x16_bf16(k0, qr[d0], p0, 0, 0, 0); p1 = __builtin_amdgcn_mfma_f32_32x32x16_bf16(k1, qr[d0], p1, 0, 0, 0); }
            if (ti >= 4) { const int j = jlo + ti - 4;
                if (j == 0) {
#pragma unroll
                    for (int r = 0; r < 16; ++r) { const int kk = crow(r, hi); if (kk < qrel) p0[r] = -INFINITY; if (kk + 32 < qrel) p1[r] = -INFINITY; } }
                else if (j == 4) {
#pragma unroll
                    for (int r = 0; r < 16; ++r) { const int kk = crow(r, hi); if (kk > qrel) p0[r] = -INFINITY; if (kk + 32 > qrel) p1[r] = -INFINITY; } } }
            float rm = fmaxf(p0[0], p1[0]);
#pragma unroll
            for (int r = 1; r < 16; ++r) rm = fmaxf(rm, fmaxf(p0[r], p1[r]));
            rm = xhalf_max(rm);
            const float mn = fmaxf(mx, rm), f = fexp2(mx - mn); mx = mn;
            float ls = 0.f;
#pragma unroll
            for (int r = 0; r < 16; ++r) { p0[r] = fexp2(p0[r] - mn); p1[r] = fexp2(p1[r] - mn); ls += p0[r] + p1[r]; }
            l = l * f + ls;
#pragma unroll
            for (int r = 0; r < 16; ++r) { o0[r] *= f; o1[r] *= f; }
            v4u pw[4];
#pragma unroll
            for (int q = 0; q < 4; ++q) { pw[0][q] = pg8::cvt_pk_bf16(p0[2 * q], p0[2 * q + 1]); pw[1][q] = pg8::cvt_pk_bf16(p0[8 + 2 * q], p0[9 + 2 * q]); pw[2][q] = pg8::cvt_pk_bf16(p1[2 * q], p1[2 * q + 1]); pw[3][q] = pg8::cvt_pk_bf16(p1[8 + 2 * q], p1[9 + 2 * q]); }
            const LAS unsigned char* vp = Vb + cur * 8192 + ((lane >> 4) & 1) * 32 + (lane & 3) * 8 + (4 * hi + ((lane & 15) >> 2)) * 64;
#pragma unroll
            for (int ks = 0; ks < 4; ++ks) { const bf16x8 pf = __builtin_bit_cast(bf16x8, pw[ks]);
                const bf16x8 v0 = MK_VFRAG(vp, ks * 1024), v1 = MK_VFRAG(vp, 4096 + ks * 1024);
                o0 = __builtin_amdgcn_mfma_f32_32x32x16_bf16(v0, pf, o0, 0, 0, 0); o1 = __builtin_amdgcn_mfma_f32_32x32x16_bf16(v1, pf, o1, 0, 0, 0); }
        }
        l = xhalf_sum(l); const float il = 1.f / l;
        bf16* yr = Y + qrow * D + h * 64 + 4 * hi;
#pragma unroll
        for (int g4 = 0; g4 < 4; ++g4) { v2u a, c2; a.x = pg8::cvt_pk_bf16(o0[4 * g4] * il, o0[4 * g4 + 1] * il); a.y = pg8::cvt_pk_bf16(o0[4 * g4 + 2] * il, o0[4 * g4 + 3] * il);
            c2.x = pg8::cvt_pk_bf16(o1[4 * g4] * il, o1[4 * g4 + 1] * il); c2.y = pg8::cvt_pk_bf16(o1[4 * g4 + 2] * il, o1[4 * g4 + 3] * il);
            *(GAS v2u*)(yr + 8 * g4) = a; *(GAS v2u*)(yr + 32 + 8 * g4) = c2; }
        __syncthreads();
    }
#undef MK_TROW
#undef MK_STAGE
}

__device__ __forceinline__ void p3_gmlp(const Ctx& C) {
    const int lane = C.lane, r32 = lane & 31, hi = lane >> 5, g = C.wave;
    const bf16* VG = C.b16(WS_VG); const bf16* U = C.b16(WS_U); const bf16* WSG = C.b16(WS_WSGM); bf16* Y = C.b16(WS_YCAT);
    LAS f32x2* stats = (LAS f32x2*)(C.lds + LDSCTL_OFF + 1024);
    LAS unsigned char* img = C.lds + g * 16384;
    for (int ck = C.vcu; ck < NTOK / 128; ck += C.G) {
        const size_t row0 = (size_t)ck * 128;
        __syncthreads();
#pragma unroll 4
        for (int i = 0; i < 16; ++i) { const int q = 16 * g + i; const v4u wv = *(const GAS v4u*)(VG + (row0 + q) * 512 + 8 * lane); f32x4 a, b2; unpack8(wv, a, b2);
            const float s = (a[0] + a[1]) + (a[2] + a[3]) + (b2[0] + b2[1]) + (b2[2] + b2[3]); const float mean = wave_sum(s) * (1.f / 512.f);
            a = a - mean; b2 = b2 - mean; const float q2 = (a[0] * a[0] + a[1] * a[1]) + (a[2] * a[2] + a[3] * a[3]) + (b2[0] * b2[0] + b2[1] * b2[1]) + (b2[2] * b2[2] + b2[3] * b2[3]);
            const float rstd = 1.f / sqrtf(wave_sum(q2) * (1.f / 512.f) + LN_EPS);
            if (lane == 0) stats[q] = (f32x2){mean, rstd}; }
        LDS_WAIT(); __syncthreads();
        { const int cc = lane & 7, ch0 = 64 * g + 8 * cc;
            const f32x4 g0 = *(const GAS f32x4*)(C.in[8] + ch0), g1 = *(const GAS f32x4*)(C.in[8] + ch0 + 4), b0 = *(const GAS f32x4*)(C.in[9] + ch0), b1 = *(const GAS f32x4*)(C.in[9] + ch0 + 4);
#pragma unroll 4
            for (int i = 0; i < 16; ++i) { const int q = 8 * i + (lane >> 3); const v4u wv = *(const GAS v4u*)(VG + (row0 + q) * 512 + ch0); f32x4 a, b2; unpack8(wv, a, b2);
                const f32x2 st = stats[q]; a = (a - st.x) * st.y * g0 + b0; b2 = (b2 - st.x) * st.y * g1 + b1;
                *(LAS v4u*)(img + (cc >> 2) * 8192 + (q >> 4) * 1024 + (q & 15) * 64 + (cc & 3) * 16) = pack8(a, b2); } }
        LDS_WAIT(); asm volatile("" ::: "memory");
        f32x16 acc[4][2];
#pragma unroll
        for (int pt = 0; pt < 4; ++pt)
#pragma unroll
            for (int ct = 0; ct < 2; ++ct)
#pragma unroll
                for (int r = 0; r < 16; ++r) acc[pt][ct][r] = 0.f;
        const LAS unsigned char* vp = img + ((lane >> 4) & 1) * 32 + (lane & 3) * 8 + (4 * hi + ((lane & 15) >> 2)) * 64;
        const bf16* wsr = WSG + ((size_t)g * 128 + r32) * 128 + 8 * hi;
#pragma unroll 2
        for (int ks = 0; ks < 8; ++ks) {
            const bf16x8 v0 = MK_VFRAG(vp, ks * 1024), v1 = MK_VFRAG(vp, 8192 + ks * 1024);
#pragma unroll
            for (int pt = 0; pt < 4; ++pt) { const bf16x8 wf = *(const GAS bf16x8*)(wsr + (size_t)pt * 32 * 128 + 16 * ks);
                acc[pt][0] = __builtin_amdgcn_mfma_f32_32x32x16_bf16(v0, wf, acc[pt][0], 0, 0, 0); acc[pt][1] = __builtin_amdgcn_mfma_f32_32x32x16_bf16(v1, wf, acc[pt][1], 0, 0, 0); }
        }
#pragma unroll
        for (int pt = 0; pt < 4; ++pt) { const int p = 32 * pt + r32; const float bsv = C.in[11][g * 128 + p];
            const bf16* ur = U + (row0 + p) * 512 + 64 * g + 4 * hi; bf16* yr = Y + (row0 + p) * D + 512 + 64 * g + 4 * hi;
#pragma unroll
            for (int ct = 0; ct < 2; ++ct)
#pragma unroll
                for (int g4 = 0; g4 < 4; ++g4) { const v2u uv = *(const GAS v2u*)(ur + 32 * ct + 8 * g4);
                    v2u o; o.x = pg8::cvt_pk_bf16(bflo(uv.x) * (acc[pt][ct][4 * g4] + bsv), bfhi(uv.x) * (acc[pt][ct][4 * g4 + 1] + bsv)); o.y = pg8::cvt_pk_bf16(bflo(uv.y) * (acc[pt][ct][4 * g4 + 2] + bsv), bfhi(uv.y) * (acc[pt][ct][4 * g4 + 3] + bsv));
                    *(GAS v2u*)(yr + 32 * ct + 8 * g4) = o; } }
    }
    __syncthreads();
}

#ifndef REP_PHASE
#define REP_PHASE -1
#endif
struct Args { const float* in[26]; float* out; unsigned char* ws; };
__global__ void __launch_bounds__(NTHR, 2) mk_fwd(Args args) {
    extern __shared__ __attribute__((aligned(16))) unsigned char lds_raw[];
    Ctx C;
#pragma unroll
    for (int i = 0; i < 26; ++i) C.in[i] = args.in[i];
    C.out = args.out; C.ws = args.ws;
    C.lds = (LAS unsigned char*)lds_raw;
    C.tid = threadIdx.x; C.lane = C.tid & 63; C.wave = __builtin_amdgcn_readfirstlane(C.tid >> 6);
    C.G = gridDim.x; { const int bx = blockIdx.x; C.vcu = (C.G % 8 == 0) ? (bx % 8) * (C.G / 8) + bx / 8 : bx; }
    volatile LAS unsigned* MISC = (volatile LAS unsigned*)(C.lds + MISC_OFF);
    for (int u = C.tid; u < (LDS_BYTES - LDSCTL_OFF) / 4; u += NTHR) ((LAS unsigned*)(C.lds + LDSCTL_OFF))[u] = 0u;
    __syncthreads();
    gu32* ctl = (gu32*)(C.ws + WS_CTL);
    XcdBarrier bar = xcd_barrier_post((unsigned*)(ctl + CW_BAR), MISC + 8);
#define GRID_BAR() do { xcd_barrier(bar); C.tid = threadIdx.x; asm volatile("" : "+v"(C.tid)); C.lane = C.tid & 63; } while (0)

    p0_prologue(C); GRID_BAR();
#if REP_PHASE == 0
    p0_prologue(C); GRID_BAR();
#endif
    p1_ln(C); GRID_BAR();
#if REP_PHASE == 1
    p1_ln(C); GRID_BAR();
#endif
    p2_inproj(C);
    GRID_BAR();
#if REP_PHASE == 2
    p2_inproj(C); GRID_BAR();
#endif
    p3_attn(C);
#if REP_PHASE == 30
    p3_attn(C);
#endif
    p3_gmlp(C);
#if REP_PHASE == 31
    p3_gmlp(C);
#endif
    GRID_BAR();
    p4_merge(C);
    GRID_BAR();
#if REP_PHASE == 4
    p4_merge(C); GRID_BAR();
#endif
    p5_wo(C);
    GRID_BAR();
    p5b_rows(C);
    GRID_BAR();
    p7_gather(C); GRID_BAR();
#if REP_PHASE == 7
    p7_gather(C); GRID_BAR();
#endif
    p8_gateup(C);
    GRID_BAR();
#if REP_PHASE == 8
    p8_gateup(C); GRID_BAR();
#endif
    p9_down(C);
    GRID_BAR();
#if REP_PHASE == 9
    p9_down(C); GRID_BAR();
#endif
#if REP_PHASE == 100
    GRID_BAR(); GRID_BAR(); GRID_BAR(); GRID_BAR(); GRID_BAR(); GRID_BAR(); GRID_BAR(); GRID_BAR(); GRID_BAR(); GRID_BAR();
#endif
    p10_final(C);
}
}

extern "C" void kernel_launch(void* const* d_in, const int* in_sizes, int n_in, void* d_out, int out_size, void* d_ws, size_t ws_size, hipStream_t stream) {
    using namespace mk;
    static int grid = 0;
    if (grid == 0) {
        if (n_in != 26 || in_sizes[0] != NTOK * D || out_size != NTOK * D || ws_size < WS_END) {
            fprintf(stderr, "kernel_launch: built for 26 inputs, x/out of %d floats, >= %zu bytes of workspace; got n_in %d, in0 %d, out %d, ws %zu; nothing launched\n", NTOK * D, (size_t)WS_END, n_in, n_in > 0 ? in_sizes[0] : -1, out_size, ws_size);
            grid = -1; return; }
        int dev = 0, cus = 0, per_cu = 0;
        if (hipGetDevice(&dev) != hipSuccess || hipDeviceGetAttribute(&cus, hipDeviceAttributeMultiprocessorCount, dev) != hipSuccess) { fprintf(stderr, "kernel_launch: device query failed\n"); grid = -1; return; }
        if (hipFuncSetAttribute((const void*)mk_fwd, hipFuncAttributeMaxDynamicSharedMemorySize, LDS_BYTES) != hipSuccess) { fprintf(stderr, "kernel_launch: hipFuncSetAttribute failed\n"); grid = -1; return; }
        if (hipOccupancyMaxActiveBlocksPerMultiprocessor(&per_cu, (const void*)mk_fwd, NTHR, LDS_BYTES) != hipSuccess || per_cu < 1) fprintf(stderr, "kernel_launch: note: occupancy query reports %d\n", per_cu);
        (void)hipGetLastError();
        grid = cus;
    }
    if (grid < 0) return;
    if (hipMemsetAsync((char*)d_ws + WS_CTL, 0, 256 * 1024, stream) != hipSuccess) { fprintf(stderr, "kernel_launch: memset failed\n"); return; }
    Args a{};
    for (int i = 0; i < 26; ++i) a.in[i] = (const float*)d_in[i];
    a.out = (float*)d_out; a.ws = (unsigned char*)d_ws;
    hipLaunchKernelGGL(mk_fwd, dim3(grid), dim3(NTHR), LDS_BYTES, stream, a);
    const hipError_t le = hipPeekAtLastError();
    if (le != hipSuccess) fprintf(stderr, "kernel_launch: launch failed: %s\n", hipGetErrorName(le));
}
```

```cpp
#include <hip/hip_runtime.h>
#include <cstdio>
#include <cstdint>
namespace pg8 {
#define PG8_LAS __attribute__((address_space(3)))
typedef unsigned short bf16_t;
typedef short bf16x8 __attribute__((ext_vector_type(8)));
typedef float f32x4 __attribute__((ext_vector_type(4)));
typedef unsigned u32x4 __attribute__((ext_vector_type(4)));
constexpr int BM = 256, BK = 64, HALF = 128, HTB = HALF * BK * 2  , STAGE_BYTES = 8 * HTB, NXCD = 8, WGM = 8;

__host__ __device__ __forceinline__ int lds_byte(int r, int c) { const int st = (r >> 4) * 2 + (c >> 5), rr = r & 15, cc = c & 31, ob = rr * 64 + cc * 2; return st * 1024 + (ob ^ (((ob >> 9) & 1) << 5)); }
__host__ __device__ __forceinline__ void stage_rc(int b, int& R, int& C) { const int st = b / 1024, sb = b % 1024, swz = sb ^ (((sb >> 9) & 1) << 5); R = (st >> 1) * 16 + swz / 64; C = (st & 1) * 32 + (swz % 64) / 2; }
__host__ __device__ __forceinline__ int perm32(int rho) { const int n = rho >> 4, i = rho & 15; return 8 * (i >> 2) + 4 * n + (i & 3); }

struct Unit { int pm, pn, pb; };
struct Gemm { const bf16_t* A; const bf16_t* Bt; int M, N, K; };

struct StaticOrder {
    int nM, nN, nwg, G, c;
    __host__ __device__ void init(int M, int N, int G_, int c_) { nM = M / BM; nN = N / BM; nwg = nM * nN; G = G_; c = c_; }
    __host__ __device__ bool next(int i, Unit& u) const {
        const long L = (long)i * G + c; if (L >= nwg) return false;
        int wgid = (int)L; { const int q = nwg / NXCD, r = nwg % NXCD, xcd = wgid % NXCD, off = wgid / NXCD; wgid = (xcd < r ? xcd * (q + 1) : r * (q + 1) + (xcd - r) * q) + off; }
        const int nig = WGM * nN, gid = wgid / nig, fm = gid * WGM, gsz = (nM - fm) < WGM ? (nM - fm) : WGM;
        u.pm = fm + ((wgid % nig) % gsz); u.pn = (wgid % nig) / gsz; u.pb = u.pn; return true;
    }
    __device__ __forceinline__ void a_ready(const Unit&) const {}
    __device__ __forceinline__ void done(const Unit&) const {}
};


__device__ __forceinline__ unsigned cvt_pk_bf16(float lo, float hi) { unsigned r; asm volatile("v_cvt_pk_bf16_f32 %0, %1, %2" : "=v"(r) : "v"(lo), "v"(hi)); return r; }
typedef float f32x2 __attribute__((ext_vector_type(2)));

struct PanelStats {
    unsigned* xbuf;
    unsigned* cnt;
    unsigned* tmo;
    int ntn; float eps;
    unsigned code;
    __device__ __forceinline__ bool run(const f32x4 (&v)[2][2][4][2], const Unit& u, int wr, int wc, int fr, int fq, PG8_LAS unsigned char* lds, int wid, int lane) const {
        typedef float f32x2v __attribute__((ext_vector_type(2)));
        PG8_LAS f32x2v* P = (PG8_LAS f32x2v*)lds;
        PG8_LAS f32x2v* S = (PG8_LAS f32x2v*)(lds + 8192);
        PG8_LAS unsigned* flag = (PG8_LAS unsigned*)(lds + 8192 + 2048);
#pragma unroll
        for (int ai = 0; ai < 2; ++ai)
#pragma unroll
            for (int m = 0; m < 4; ++m) {
                float s = 0.f;
#pragma unroll
                for (int bj = 0; bj < 2; ++bj)
#pragma unroll
                    for (int n = 0; n < 2; ++n) { const f32x4 x = v[ai][bj][m][n]; s += (x[0] + x[1]) + (x[2] + x[3]); }
                s += __shfl_xor(s, 16); s += __shfl_xor(s, 32);
                const float mw = s * (1.0f / 64.0f); float q = 0.f;
#pragma unroll
                for (int bj = 0; bj < 2; ++bj)
#pragma unroll
                    for (int n = 0; n < 2; ++n) { const f32x4 d = v[ai][bj][m][n] - mw; q += (d[0] * d[0] + d[1] * d[1]) + (d[2] * d[2] + d[3] * d[3]); }
                q += __shfl_xor(q, 16); q += __shfl_xor(q, 32);
                if (fq == 0) P[(ai * HALF + wr * 64 + m * 16 + fr) * 4 + wc] = (f32x2v){mw, q};
            }
        asm volatile("s_waitcnt lgkmcnt(0)" ::: "memory"); __builtin_amdgcn_s_barrier(); asm volatile("" ::: "memory");
#if defined(BROKEN_EXCHANGE_NO_WAIT)
#warning BROKEN CONTROL BUILD: the row-statistics exchange does not wait; results are wrong by design
        if (blockIdx.x >= 64) { const long long t0_ = clock64(); while (clock64() - t0_ < 60000) __builtin_amdgcn_s_sleep(8); }
#endif
        const int row = wid * 32 + (lane & 31);
        if (lane < 32) {
            const f32x2v a = P[row * 4 + 0], b = P[row * 4 + 1], c = P[row * 4 + 2], d = P[row * 4 + 3];
            const float mt = (a.x + b.x + c.x + d.x) * 0.25f;
            const float da = a.x - mt, db = b.x - mt, dc = c.x - mt, dd = d.x - mt;
            const float m2 = (a.y + b.y) + (c.y + d.y) + 64.0f * ((da * da + db * db) + (dc * dc + dd * dd));
            unsigned long long* slot = (unsigned long long*)xbuf + ((size_t)(u.pm * BM + row) * 4 + u.pn);
            __hip_atomic_store(slot, ((unsigned long long)__float_as_uint(m2) << 32) | __float_as_uint(mt), __ATOMIC_RELAXED, __HIP_MEMORY_SCOPE_AGENT);
        }
        asm volatile("s_waitcnt vmcnt(0)" ::: "memory");
        if (lane == 0) __hip_atomic_fetch_add(cnt + 64 * u.pm, 1u, __ATOMIC_RELAXED, __HIP_MEMORY_SCOPE_AGENT);
        if (wid == 0) {
            bool dead = false; const unsigned long long t0 = __builtin_amdgcn_s_memrealtime(); const unsigned want = 8u * (unsigned)ntn;
            for (;;) {
#if defined(BROKEN_EXCHANGE_NO_WAIT)
                break;
#endif
                if ((unsigned)__builtin_amdgcn_readfirstlane(__hip_atomic_load(cnt + 64 * u.pm, __ATOMIC_RELAXED, __HIP_MEMORY_SCOPE_AGENT)) >= want) break;
                if (__builtin_amdgcn_s_memrealtime() - t0 > 2000000ull) {
                    if (lane == 0) { unsigned expect = 0u; __hip_atomic_compare_exchange_strong(tmo + 1, &expect, code | (unsigned)(u.pm & 0xff), __ATOMIC_RELAXED, __ATOMIC_RELAXED, __HIP_MEMORY_SCOPE_AGENT);
                                     __hip_atomic_store(tmo, 1u, __ATOMIC_RELAXED, __HIP_MEMORY_SCOPE_AGENT); }
                    dead = true; break; }
                __builtin_amdgcn_s_sleep(2);
            }
            __builtin_amdgcn_fence(__ATOMIC_ACQUIRE, "agent");
            if (lane == 0) flag[0] = dead ? 1u : 0u;
        }
        asm volatile("s_waitcnt vmcnt(0) lgkmcnt(0)" ::: "memory"); __builtin_amdgcn_s_barrier(); asm volatile("" ::: "memory");
        const bool bad = flag[0] != 0u;
        if (lane < 32) {
            const unsigned long long* slot = (const unsigned long long*)xbuf + (size_t)(u.pm * BM + row) * 4; float mt[4], m2[4]; float ms = 0.f;
#pragma unroll
            for (int t = 0; t < 4; ++t) { if (t < ntn) { const unsigned long long w = __hip_atomic_load(slot + t, __ATOMIC_RELAXED, __HIP_MEMORY_SCOPE_AGENT); mt[t] = __uint_as_float((unsigned)w); m2[t] = __uint_as_float((unsigned)(w >> 32)); } else { mt[t] = 0.f; m2[t] = 0.f; } ms += mt[t]; }
            const float mean = ms / (float)ntn; float q = 0.f;
#pragma unroll
            for (int t = 0; t < 4; ++t) if (t < ntn) { const float dm = mt[t] - mean; q += m2[t] + 256.0f * dm * dm; }
            S[row] = (f32x2v){mean, 1.0f / sqrtf(q / (256.0f * (float)ntn) + eps)};
        }
        asm volatile("s_waitcnt lgkmcnt(0)" ::: "memory"); __builtin_amdgcn_s_barrier(); asm volatile("" ::: "memory");
        return bad;
    }
};

template <class Epi, class Sched, bool ALIGN_EPI = false, bool SP2 = false>
__device__ __forceinline__ void gemm_phase(PG8_LAS unsigned char* lds, const Gemm g, const Sched& S, const Epi& E, const int wave_id) {
    int tid = wave_id * 64 + (int)__builtin_amdgcn_mbcnt_hi(~0u, __builtin_amdgcn_mbcnt_lo(~0u, 0u)); asm volatile("" : "+v"(tid));
    const int wid = __builtin_amdgcn_readfirstlane(tid >> 6), lane = tid & 63, wr = wid >> 2, wc = wid & 3, fr = lane & 15, fq = lane >> 4;
    const int K = g.K, nt = K / BK;
    unsigned voffA[2], voffB[2];
#pragma unroll
    for (int i = 0; i < 2; ++i) { int R, C; stage_rc(tid * 16 + i * 8192, R, C); const int Rb = Epi::PERM ? ((R & ~31) + perm32(R & 31)) : R;
        voffA[i] = (unsigned)(R * K + C) * 2u; voffB[i] = (unsigned)(Rb * K + C) * 2u; }
    const size_t kstep = (size_t)(BK * 2);
    const size_t hstep = (size_t)HALF * K * 2;
    const size_t tstep = 2 * hstep;
    const unsigned ldsw = (unsigned)wid * 1024u;
    const int aoff = lds_byte(wr * 64 + fr, fq * 8), boff = lds_byte(wc * 32 + fr, fq * 8);
#define PG8_SA(b, h) (((b) * 2 + (h)) * HTB)
#define PG8_SB(b, h) ((4 + (b) * 2 + (h)) * HTB)
#define PG8_STAGE(bufoff, gbase, voff) do { _Pragma("unroll") for (int _i = 0; _i < 2; ++_i) \
        __builtin_amdgcn_global_load_lds((const unsigned*)((const char*)(gbase) + (voff)[_i]), (PG8_LAS unsigned*)(lds + (bufoff) + ldsw + _i * 8192), 16, 0, 0); } while (0)
#define PG8_LDA(dst, b, h) do { _Pragma("unroll") for (int m = 0; m < 4; ++m) _Pragma("unroll") for (int k = 0; k < 2; ++k) dst[m][k] = *(const PG8_LAS bf16x8*)(lds + PG8_SA(b, h) + aoff + m * 2048 + k * 1024); } while (0)
#define PG8_LDB(dst, b, h) do { _Pragma("unroll") for (int n = 0; n < 2; ++n) _Pragma("unroll") for (int k = 0; k < 2; ++k) dst[n][k] = *(const PG8_LAS bf16x8*)(lds + PG8_SB(b, h) + boff + n * 2048 + k * 1024); } while (0)
#define PG8_MMA(ai, bj, At, Bt) do { __builtin_amdgcn_s_setprio(1); _Pragma("unroll") for (int m = 0; m < 4; ++m) _Pragma("unroll") for (int n = 0; n < 2; ++n) _Pragma("unroll") for (int k = 0; k < 2; ++k) \
        acc[ai][bj][m][n] = __builtin_amdgcn_mfma_f32_16x16x32_bf16(Bt[n][k], At[m][k], acc[ai][bj][m][n], 0, 0, 0); __builtin_amdgcn_s_setprio(0); } while (0)
#define PG8_WAIT_V(n) asm volatile("s_waitcnt vmcnt(" #n ")" ::: "memory")
#define PG8_WAIT_L(n) asm volatile("s_waitcnt lgkmcnt(" #n ")" ::: "memory")
#define PG8_BAR __builtin_amdgcn_s_barrier()
#define PG8_SCHED __builtin_amdgcn_sched_barrier(0)
    Unit cur, nxt; int ui = 0;
    if (!S.next(0, cur)) return;
    f32x4 acc[2][2][4][2];
#pragma unroll
    for (int a = 0; a < 2; ++a)
#pragma unroll
        for (int b = 0; b < 2; ++b)
#pragma unroll
            for (int m = 0; m < 4; ++m)
#pragma unroll
                for (int n = 0; n < 2; ++n) acc[a][b][m][n] = (f32x4){0.f, 0.f, 0.f, 0.f};
    bf16x8 At[4][2], B0[2][2], B1[2][2];
    const char* cA = (const char*)g.A + (size_t)cur.pm * tstep; const char* cB = (const char*)g.Bt + (size_t)cur.pb * tstep;
    S.a_ready(cur);
    if constexpr (SP2) {
        PG8_STAGE(PG8_SB(0, 0), cB, voffB); PG8_STAGE(PG8_SB(0, 1), cB + hstep, voffB); PG8_STAGE(PG8_SA(0, 0), cA, voffA); PG8_STAGE(PG8_SA(0, 1), cA + hstep, voffA);
        if (wr == 1) PG8_BAR;
        PG8_WAIT_V(2); PG8_BAR;
        PG8_STAGE(PG8_SB(1, 0), cB + kstep, voffB); PG8_STAGE(PG8_SA(1, 0), cA + kstep, voffA); PG8_STAGE(PG8_SB(1, 1), cB + hstep + kstep, voffB);
        PG8_WAIT_V(6); PG8_BAR;
    } else {
        PG8_STAGE(PG8_SB(0, 0), cB, voffB); PG8_STAGE(PG8_SA(0, 0), cA, voffA); PG8_STAGE(PG8_SB(0, 1), cB + hstep, voffB); PG8_STAGE(PG8_SA(0, 1), cA + hstep, voffA);
        if (wr == 1) PG8_BAR;
        PG8_WAIT_V(4); PG8_BAR;
        PG8_STAGE(PG8_SB(1, 0), cB + kstep, voffB); PG8_STAGE(PG8_SA(1, 0), cA + kstep, voffA); PG8_STAGE(PG8_SB(1, 1), cB + hstep + kstep, voffB);
        PG8_WAIT_V(6); PG8_BAR;
    }
    for (;;) {
        const bool has_next = S.next(ui + 1, nxt);
        const char* nA = has_next ? (const char*)g.A + (size_t)nxt.pm * tstep : cA; const char* nB = has_next ? (const char*)g.Bt + (size_t)nxt.pb * tstep : cB;
        for (int t = 0; t < nt; t += 2) {
            const bool last = (t == nt - 2);
            const char* a1 = cA + (size_t)(t + 1) * kstep;
            const char* a2 = last ? nA : cA + (size_t)(t + 2) * kstep; const char* b2 = last ? nB : cB + (size_t)(t + 2) * kstep;
            const char* a3 = a2 + kstep; const char* b3 = b2 + kstep;
            if (last && has_next) S.a_ready(nxt);
            if constexpr (Epi::MID_T > 0) { if (t == Epi::MID_T) E.mid(acc, cur, wr, wc, fr, fq); }
            if constexpr (SP2) {
            PG8_LDB(B0, 0, 0); PG8_LDB(B1, 0, 1); PG8_SCHED; PG8_LDA(At, 0, 0); PG8_STAGE(PG8_SA(1, 1), a1 + hstep, voffA);
            PG8_WAIT_V(8); PG8_WAIT_L(0); PG8_BAR; PG8_MMA(0, 0, At, B0); PG8_MMA(0, 1, At, B1); PG8_BAR; PG8_SCHED;
            PG8_LDA(At, 0, 1); PG8_STAGE(PG8_SB(0, 0), b2, voffB); PG8_STAGE(PG8_SB(0, 1), b2 + hstep, voffB); PG8_STAGE(PG8_SA(0, 0), a2, voffA);
            PG8_WAIT_V(8); PG8_WAIT_L(0); PG8_BAR; PG8_MMA(1, 0, At, B0); PG8_MMA(1, 1, At, B1); PG8_BAR; PG8_SCHED;
            PG8_LDB(B0, 1, 0); PG8_LDB(B1, 1, 1); PG8_SCHED; PG8_LDA(At, 1, 0); PG8_STAGE(PG8_SA(0, 1), a2 + hstep, voffA);
            PG8_WAIT_V(8); PG8_WAIT_L(0); PG8_BAR; PG8_MMA(0, 0, At, B0); PG8_MMA(0, 1, At, B1); PG8_BAR; PG8_SCHED;
            PG8_LDA(At, 1, 1); PG8_STAGE(PG8_SB(1, 0), b3, voffB); PG8_STAGE(PG8_SB(1, 1), b3 + hstep, voffB); PG8_STAGE(PG8_SA(1, 0), a3, voffA);
            PG8_WAIT_V(8); PG8_WAIT_L(0); PG8_BAR; PG8_MMA(1, 0, At, B0); PG8_MMA(1, 1, At, B1); PG8_BAR; PG8_SCHED;
            } else {
            PG8_LDB(B0, 0, 0); PG8_SCHED; PG8_LDA(At, 0, 0); PG8_STAGE(PG8_SA(1, 1), a1 + hstep, voffA);
            PG8_WAIT_L(8); PG8_BAR; PG8_WAIT_L(0); PG8_MMA(0, 0, At, B0); PG8_BAR; PG8_SCHED;
            PG8_LDB(B1, 0, 1); PG8_STAGE(PG8_SB(0, 0), b2, voffB);
            PG8_BAR; PG8_WAIT_L(0); PG8_MMA(0, 1, At, B1); PG8_BAR;
            PG8_LDA(At, 0, 1); PG8_STAGE(PG8_SA(0, 0), a2, voffA);
            PG8_BAR; PG8_WAIT_L(0); PG8_MMA(1, 0, At, B0); PG8_BAR; PG8_SCHED;
            PG8_STAGE(PG8_SB(0, 1), b2 + hstep, voffB);
            PG8_WAIT_V(6); PG8_BAR; PG8_MMA(1, 1, At, B1); PG8_BAR;
            PG8_LDB(B0, 1, 0); PG8_SCHED; PG8_LDA(At, 1, 0); PG8_STAGE(PG8_SA(0, 1), a2 + hstep, voffA);
            PG8_WAIT_L(8); PG8_BAR; PG8_WAIT_L(0); PG8_MMA(0, 0, At, B0); PG8_BAR; PG8_SCHED;
            PG8_LDB(B1, 1, 1); PG8_STAGE(PG8_SB(1, 0), b3, voffB);
            PG8_BAR; PG8_WAIT_L(0); PG8_MMA(0, 1, At, B1); PG8_BAR;
            PG8_LDA(At, 1, 1); PG8_STAGE(PG8_SA(1, 0), a3, voffA);
            PG8_BAR; PG8_WAIT_L(0); PG8_MMA(1, 0, At, B0); PG8_BAR; PG8_SCHED;
            PG8_STAGE(PG8_SB(1, 1), b3 + hstep, voffB);
            PG8_WAIT_V(6); PG8_BAR; PG8_MMA(1, 1, At, B1); PG8_BAR;
            }
        }
        if constexpr (ALIGN_EPI) { if (wr == 0) PG8_BAR; }
        if constexpr (!Epi::AFTER_DRAIN) { E(acc, cur, wr, wc, fr, fq); S.done(cur); }
        if (!has_next) break;
#pragma unroll
        for (int a = 0; a < 2; ++a)
#pragma unroll
            for (int b = 0; b < 2; ++b)
#pragma unroll
                for (int m = 0; m < 4; ++m)
#pragma unroll
                    for (int n = 0; n < 2; ++n) acc[a][b][m][n] = (f32x4){0.f, 0.f, 0.f, 0.f};
        cur = nxt; cA = nA; cB = nB; ++ui;
        if constexpr (ALIGN_EPI) { if (wr == 1) PG8_BAR; }
    }
    PG8_WAIT_V(0);
    if constexpr (!ALIGN_EPI) { if (wr == 0) PG8_BAR; }
    PG8_BAR;
    if constexpr (Epi::AFTER_DRAIN) { E.fused(acc, cur, wr, wc, fr, fq, lds, wid, lane); S.done(cur); }
#undef PG8_SA
#undef PG8_SB
#undef PG8_STAGE
#undef PG8_LDA
#undef PG8_LDB
#undef PG8_MMA
#undef PG8_WAIT_V
#undef PG8_WAIT_L
#undef PG8_BAR
#undef PG8_SCHED
}
typedef int i32x4 __attribute__((ext_vector_type(4)));
typedef int i32x8 __attribute__((ext_vector_type(8)));
typedef float f32x16v __attribute__((ext_vector_type(16)));
__host__ __device__ __forceinline__ void stage_rc8(int b, int& R, int& Cb) { const int st = b / 1024, sb = b % 1024, g = sb / 64, sl = (sb % 64) / 16, fr = 4 * (g & 3) + (g >> 2), q = (sl - (g >> 2)) & 3; R = (st >> 1) * 16 + fr; Cb = (st & 1) * 64 + 16 * q; }
__host__ __device__ __forceinline__ int lds_byte8(int r, int fq, int pc) { return ((r >> 4) * 2 + (fq >> 1)) * 1024 + 64 * (4 * (r & 3) + ((r & 15) >> 2)) + 16 * ((2 * (fq & 1) + pc + (r & 3)) & 3); }
template <class Epi, class Sched, bool ALIGN_EPI = false, bool SP2 = false>
__device__ __forceinline__ void gemm_phase8(PG8_LAS unsigned char* lds, const Gemm g, const Sched& S, const Epi& E, const int wave_id) {
    int tid = wave_id * 64 + (int)__builtin_amdgcn_mbcnt_hi(~0u, __builtin_amdgcn_mbcnt_lo(~0u, 0u)); asm volatile("" : "+v"(tid));
    const int wid = __builtin_amdgcn_readfirstlane(tid >> 6), lane = tid & 63, wr = wid >> 2, wc = wid & 3, fr = lane & 15, fq = lane >> 4;
    const int K = g.K, nt = K / 128;
    unsigned voffA, voffB;
    { int R, Cb; stage_rc8(tid * 16, R, Cb); const int Rb = Epi::PERM ? ((R & ~31) + perm32(R & 31)) : R;
        voffA = (unsigned)(R * K + Cb); voffB = (unsigned)(Rb * K + Cb); }
    const size_t kstep = (size_t)(BK * 2);
    const size_t hstep = (size_t)HALF * K;
    const size_t tstep = 2 * hstep;
    const unsigned ldsw = (unsigned)wid * 1024u;
    const int aoff = lds_byte8(wr * 64 + fr, fq, 0), aoff1 = lds_byte8(wr * 64 + fr, fq, 1), boff = lds_byte8(wc * 32 + fr, fq, 0), boff1 = lds_byte8(wc * 32 + fr, fq, 1);
#define PG8_SA(b, h) (((b) * 2 + (h)) * HTB)
#define PG8_SB(b, h) ((4 + (b) * 2 + (h)) * HTB)
#define PG8_STAGE(bufoff, gbase, voff) do { _Pragma("unroll") for (int _i = 0; _i < 2; ++_i) \
        __builtin_amdgcn_global_load_lds((const unsigned*)((const char*)(gbase) + (size_t)_i * 64 * K + (voff)), (PG8_LAS unsigned*)(lds + (bufoff) + ldsw + _i * 8192), 16, 0, 0); } while (0)
#define PG8_LDA(dst, b, h) do { _Pragma("unroll") for (int m = 0; m < 4; ++m) { const i32x4 lo_ = *(const PG8_LAS i32x4*)(lds + PG8_SA(b, h) + aoff + m * 2048), hi_ = *(const PG8_LAS i32x4*)(lds + PG8_SA(b, h) + aoff1 + m * 2048); dst[m] = (i32x8){lo_[0], lo_[1], lo_[2], lo_[3], hi_[0], hi_[1], hi_[2], hi_[3]}; } } while (0)
#define PG8_LDB(dst, b, h) do { _Pragma("unroll") for (int n = 0; n < 2; ++n) { const i32x4 lo_ = *(const PG8_LAS i32x4*)(lds + PG8_SB(b, h) + boff + n * 2048), hi_ = *(const PG8_LAS i32x4*)(lds + PG8_SB(b, h) + boff1 + n * 2048); dst[n] = (i32x8){lo_[0], lo_[1], lo_[2], lo_[3], hi_[0], hi_[1], hi_[2], hi_[3]}; } } while (0)
#define PG8_MMA(ai, bj, At, Bt) do { __builtin_amdgcn_s_setprio(1); _Pragma("unroll") for (int m = 0; m < 4; ++m) _Pragma("unroll") for (int n = 0; n < 2; ++n) { \
        const int o_ = 4 * (2 * (bj) + n); f32x4 c_ = (f32x4){acc16[ai][m][o_], acc16[ai][m][o_ + 1], acc16[ai][m][o_ + 2], acc16[ai][m][o_ + 3]}; \
        c_ = __builtin_amdgcn_mfma_scale_f32_16x16x128_f8f6f4(Bt[n], At[m], c_, 0, 0, 0, 0x7F7F7F7F, 0, 0x7F7F7F7F); \
        acc16[ai][m][o_] = c_[0]; acc16[ai][m][o_ + 1] = c_[1]; acc16[ai][m][o_ + 2] = c_[2]; acc16[ai][m][o_ + 3] = c_[3]; } __builtin_amdgcn_s_setprio(0); } while (0)
#define PG8_WAIT_V(n) asm volatile("s_waitcnt vmcnt(" #n ")" ::: "memory")
#define PG8_WAIT_L(n) asm volatile("s_waitcnt lgkmcnt(" #n ")" ::: "memory")
#define PG8_BAR __builtin_amdgcn_s_barrier()
#define PG8_SCHED __builtin_amdgcn_sched_barrier(0)
    Unit cur, nxt; int ui = 0;
    if (!S.next(0, cur)) return;
    f32x16v acc16[2][4];
#pragma unroll
    for (int a = 0; a < 2; ++a)
#pragma unroll
        for (int m = 0; m < 4; ++m) {
#pragma unroll
            for (int e = 0; e < 16; ++e) acc16[a][m][e] = 0.f;
        }
    i32x8 At[4], B0[2], B1[2];
    const char* cA = (const char*)g.A + (size_t)cur.pm * tstep; const char* cB = (const char*)g.Bt + (size_t)cur.pb * tstep;
    S.a_ready(cur);
    if constexpr (SP2) {
        PG8_STAGE(PG8_SB(0, 0), cB, voffB); PG8_STAGE(PG8_SB(0, 1), cB + hstep, voffB); PG8_STAGE(PG8_SA(0, 0), cA, voffA); PG8_STAGE(PG8_SA(0, 1), cA + hstep, voffA);
        if (wr == 1) PG8_BAR;
        PG8_WAIT_V(2); PG8_BAR;
        PG8_STAGE(PG8_SB(1, 0), cB + kstep, voffB); PG8_STAGE(PG8_SA(1, 0), cA + kstep, voffA); PG8_STAGE(PG8_SB(1, 1), cB + hstep + kstep, voffB);
        PG8_WAIT_V(6); PG8_BAR;
    } else {
        PG8_STAGE(PG8_SB(0, 0), cB, voffB); PG8_STAGE(PG8_SA(0, 0), cA, voffA); PG8_STAGE(PG8_SB(0, 1), cB + hstep, voffB); PG8_STAGE(PG8_SA(0, 1), cA + hstep, voffA);
        if (wr == 1) PG8_BAR;
        PG8_WAIT_V(4); PG8_BAR;
        PG8_STAGE(PG8_SB(1, 0), cB + kstep, voffB); PG8_STAGE(PG8_SA(1, 0), cA + kstep, voffA); PG8_STAGE(PG8_SB(1, 1), cB + hstep + kstep, voffB);
        PG8_WAIT_V(6); PG8_BAR;
    }
    for (;;) {
        const bool has_next = S.next(ui + 1, nxt);
        const char* nA = has_next ? (const char*)g.A + (size_t)nxt.pm * tstep : cA; const char* nB = has_next ? (const char*)g.Bt + (size_t)nxt.pb * tstep : cB;
        for (int t = 0; t < nt; t += 2) {
            const bool last = (t == nt - 2);
            const char* a1 = cA + (size_t)(t + 1) * kstep;
            const char* a2 = last ? nA : cA + (size_t)(t + 2) * kstep; const char* b2 = last ? nB : cB + (size_t)(t + 2) * kstep;
            const char* a3 = a2 + kstep; const char* b3 = b2 + kstep;
            if (last && has_next) S.a_ready(nxt);
            if constexpr (SP2) {
            PG8_LDB(B0, 0, 0); PG8_LDB(B1, 0, 1); PG8_SCHED; PG8_LDA(At, 0, 0); PG8_STAGE(PG8_SA(1, 1), a1 + hstep, voffA);
            PG8_WAIT_V(8); PG8_WAIT_L(0); PG8_BAR; PG8_MMA(0, 0, At, B0); PG8_MMA(0, 1, At, B1); PG8_BAR; PG8_SCHED;
            PG8_LDA(At, 0, 1); PG8_STAGE(PG8_SB(0, 0), b2, voffB); PG8_STAGE(PG8_SB(0, 1), b2 + hstep, voffB); PG8_STAGE(PG8_SA(0, 0), a2, voffA);
            PG8_WAIT_V(8); PG8_WAIT_L(0); PG8_BAR; PG8_MMA(1, 0, At, B0); PG8_MMA(1, 1, At, B1); PG8_BAR; PG8_SCHED;
            PG8_LDB(B0, 1, 0); PG8_LDB(B1, 1, 1); PG8_SCHED; PG8_LDA(At, 1, 0); PG8_STAGE(PG8_SA(0, 1), a2 + hstep, voffA);
            PG8_WAIT_V(8); PG8_WAIT_L(0); PG8_BAR; PG8_MMA(0, 0, At, B0); PG8_MMA(0, 1, At, B1); PG8_BAR; PG8_SCHED;
            PG8_LDA(At, 1, 1); PG8_STAGE(PG8_SB(1, 0), b3, voffB); PG8_STAGE(PG8_SB(1, 1), b3 + hstep, voffB); PG8_STAGE(PG8_SA(1, 0), a3, voffA);
            PG8_WAIT_V(8); PG8_WAIT_L(0); PG8_BAR; PG8_MMA(1, 0, At, B0); PG8_MMA(1, 1, At, B1); PG8_BAR; PG8_SCHED;
            } else {
            PG8_LDB(B0, 0, 0); PG8_SCHED; PG8_LDA(At, 0, 0); PG8_STAGE(PG8_SA(1, 1), a1 + hstep, voffA);
            PG8_WAIT_L(8); PG8_BAR; PG8_WAIT_L(0); PG8_MMA(0, 0, At, B0); PG8_BAR; PG8_SCHED;
            PG8_LDB(B1, 0, 1); PG8_STAGE(PG8_SB(0, 0), b2, voffB);
            PG8_BAR; PG8_WAIT_L(0); PG8_MMA(0, 1, At, B1); PG8_BAR;
            PG8_LDA(At, 0, 1); PG8_STAGE(PG8_SA(0, 0), a2, voffA);
            PG8_BAR; PG8_WAIT_L(0); PG8_MMA(1, 0, At, B0); PG8_BAR; PG8_SCHED;
            PG8_STAGE(PG8_SB(0, 1), b2 + hstep, voffB);
            PG8_WAIT_V(6); PG8_BAR; PG8_MMA(1, 1, At, B1); PG8_BAR;
            PG8_LDB(B0, 1, 0); PG8_SCHED; PG8_LDA(At, 1, 0); PG8_STAGE(PG8_SA(0, 1), a2 + hstep, voffA);
            PG8_WAIT_L(8); PG8_BAR; PG8_WAIT_L(0); PG8_MMA(0, 0, At, B0); PG8_BAR; PG8_SCHED;
            PG8_LDB(B1, 1, 1); PG8_STAGE(PG8_SB(1, 0), b3, voffB);
            PG8_BAR; PG8_WAIT_L(0); PG8_MMA(0, 1, At, B1); PG8_BAR;
            PG8_LDA(At, 1, 1); PG8_STAGE(PG8_SA(1, 0), a3, voffA);
            PG8_BAR; PG8_WAIT_L(0); PG8_MMA(1, 0, At, B0); PG8_BAR; PG8_SCHED;
            PG8_STAGE(PG8_SB(1, 1), b3 + hstep, voffB);
            PG8_WAIT_V(6); PG8_BAR; PG8_MMA(1, 1, At, B1); PG8_BAR;
            }
        }
        if constexpr (ALIGN_EPI) { if (wr == 0) PG8_BAR; }
        if constexpr (!Epi::AFTER_DRAIN) { f32x4 acc[2][2][4][2];
_Pragma("unroll") for (int a_ = 0; a_ < 2; ++a_) _Pragma("unroll") for (int b_ = 0; b_ < 2; ++b_) _Pragma("unroll") for (int m_ = 0; m_ < 4; ++m_) _Pragma("unroll") for (int n_ = 0; n_ < 2; ++n_) { const int o_ = 4 * (2 * b_ + n_); acc[a_][b_][m_][n_] = (f32x4){acc16[a_][m_][o_], acc16[a_][m_][o_ + 1], acc16[a_][m_][o_ + 2], acc16[a_][m_][o_ + 3]}; }
          E(acc, cur, wr, wc, fr, fq); S.done(cur); }
        if (!has_next) break;
#pragma unroll
    for (int a = 0; a < 2; ++a)
#pragma unroll
        for (int m = 0; m < 4; ++m) {
#pragma unroll
            for (int e = 0; e < 16; ++e) acc16[a][m][e] = 0.f;
        }
        cur = nxt; cA = nA; cB = nB; ++ui;
        if constexpr (ALIGN_EPI) { if (wr == 1) PG8_BAR; }
    }
    PG8_WAIT_V(0);
    if constexpr (!ALIGN_EPI) { if (wr == 0) PG8_BAR; }
    PG8_BAR;
    static_assert(!Epi::AFTER_DRAIN, "fp8 body: streaming epilogues only");
#undef PG8_SA
#undef PG8_SB
#undef PG8_STAGE
#undef PG8_LDA
#undef PG8_LDB
#undef PG8_MMA
#undef PG8_WAIT_V
#undef PG8_WAIT_L
#undef PG8_BAR
#undef PG8_SCHED
}
}

#define GAS __attribute__((address_space(1)))
#define LAS __attribute__((address_space(3)))
typedef unsigned short bf16;
typedef unsigned v4u __attribute__((ext_vector_type(4)));
typedef float f32x4 __attribute__((ext_vector_type(4)));
typedef short bf16x8 __attribute__((ext_vector_type(8)));
typedef GAS unsigned gu32;
typedef GAS unsigned long long gu64;
#define RLX_AGENT __ATOMIC_RELAXED, __HIP_MEMORY_SCOPE_AGENT
#define LDS_WAIT() asm volatile("s_waitcnt lgkmcnt(0)" ::: "memory")
#define VM_WAIT() asm volatile("s_waitcnt vmcnt(0)" ::: "memory")
__device__ __forceinline__ unsigned long long rt() { return __builtin_amdgcn_s_memrealtime(); }
__device__ __forceinline__ unsigned f2bf(float f) { unsigned u = __builtin_bit_cast(unsigned, f); return (u + 0x7fffu + ((u >> 16) & 1u)) >> 16; }
__device__ __forceinline__ unsigned pk2(float lo, float hi) { return f2bf(lo) | (f2bf(hi) << 16); }

#define XB_TMO      128
#define XB_XCNT(j)  (256  + 64 * (j))
#define XB_XSUB(j)  (1280 + 64 * (j))
#define XB_XGEN(j)  (2304 + 64 * (j))
#define XB_TOP      3328
#define XB_TOPGEN   3392
#define XCD_BAR_WORDS 3456
#define XB_SPIN_CAP (1u << 20)

__device__ __forceinline__ unsigned xb_ld(unsigned* p)              { return __hip_atomic_load(p, __ATOMIC_RELAXED, __HIP_MEMORY_SCOPE_AGENT); }
__device__ __forceinline__ unsigned xb_add(unsigned* p, unsigned v) { return __hip_atomic_fetch_add(p, v, __ATOMIC_RELAXED, __HIP_MEMORY_SCOPE_AGENT); }
__device__ __forceinline__ unsigned xb_xcc_id() { return (unsigned)__builtin_amdgcn_s_getreg((3 << 11) | 20) & 0xFu; }
#define XB_SPIN(cond, bar) do { unsigned _sp = 0; while (cond) { __builtin_amdgcn_s_sleep(1); \
    if ((++_sp & 255u) == 0u) { if (xb_ld(&(bar)[XB_TMO])) break; if (_sp > XB_SPIN_CAP) { atomicAdd(&(bar)[XB_TMO], 1u); break; } } } } while (0)

struct XcdBarrier {
    unsigned* bar; unsigned x;
    volatile LAS unsigned* st;
};

__device__ __forceinline__ XcdBarrier xcd_barrier_post(unsigned* bar, volatile LAS unsigned* st, const int tid) {
    XcdBarrier b; b.bar = bar; b.x = xb_xcc_id(); b.st = st;
    if (tid == 0) (void)xb_add(&bar[XB_XCNT(b.x)], 1u);
    return b;
}
__device__ __forceinline__ void xcd_barrier_complete(unsigned* bar, unsigned x, unsigned& nloc, unsigned& nx) {
    const unsigned G = gridDim.x * gridDim.y * gridDim.z;
    unsigned sum, cnt, mine, sp = 0u;
    for (;;) {
        sum = 0u; cnt = 0u; mine = 0u;
#pragma unroll
        for (unsigned j = 0; j < 16; ++j) { const unsigned c = xb_ld(&bar[XB_XCNT(j)]); sum += c; cnt += (c > 0u) ? 1u : 0u; mine = (j == x) ? c : mine; }
        if (sum == G) break;
        __builtin_amdgcn_s_sleep(1);
        if ((++sp & 255u) == 0u) { if (xb_ld(&bar[XB_TMO])) break; if (sp > XB_SPIN_CAP) { atomicAdd(&bar[XB_TMO], 1u); break; } }
    }
    nloc = mine > 0u ? mine : 1u; nx = cnt > 0u ? cnt : 1u;
}

__device__ __forceinline__ void xcd_barrier(const XcdBarrier& b, const int tid) {
    asm volatile("s_waitcnt vmcnt(0)" ::: "memory");
    __syncthreads();
    if (tid == 0) {
        unsigned* bar = b.bar;
        __builtin_amdgcn_s_waitcnt(0);
        unsigned nloc = b.st[0], nx = b.st[1];
        if (nloc == 0u) { xcd_barrier_complete(bar, b.x, nloc, nx); b.st[0] = nloc; b.st[1] = nx; }
        const unsigned old = xb_add(&bar[XB_XSUB(b.x)], 1u);
        const unsigned gen = old / nloc;
        if (old + 1u == (gen + 1u) * nloc) {
            __builtin_amdgcn_fence(__ATOMIC_RELEASE, "agent");
            asm volatile("s_waitcnt vmcnt(0)" ::: "memory");
            const unsigned og = xb_add(&bar[XB_TOP], 1u);
            const unsigned tg = og / nx;
            if (og + 1u == (tg + 1u) * nx) xb_add(&bar[XB_TOPGEN], 1u);
            else XB_SPIN(xb_ld(&bar[XB_TOPGEN]) == tg, bar);
            __builtin_amdgcn_fence(__ATOMIC_ACQUIRE, "agent");
            xb_add(&bar[XB_XGEN(b.x)], 1u);
            asm volatile("s_waitcnt vmcnt(0)" ::: "memory");
        } else {
            XB_SPIN(xb_ld(&bar[XB_XGEN(b.x)]) == gen, bar);
            __builtin_amdgcn_fence(__ATOMIC_ACQUIRE, "agent");
            asm volatile("s_waitcnt vmcnt(0)" ::: "memory");
        }
    }
    __syncthreads();
}

namespace mk {
constexpr int D = 1024, BATCH = 4, SEQ = 8192, CTX = 256, NTOK = BATCH * SEQ;
constexpr int INW = 3840, KVB = CTX + SEQ, KVROWS = BATCH * KVB, HROWS = NTOK + BATCH * CTX;
constexpr int NEXP = 32, DEXP = 512, XG_ROWS = 73728, MAXTILES = XG_ROWS / 256;
constexpr float LN_EPS = 1e-6f, ALPHA = 1.189207115002721f, LOG2E = 1.4426950408889634f, QSCALE = 0.125f * 1.4426950408889634f;
constexpr size_t MiB = 1u << 20;
constexpr size_t WS_CTL = 0, CTL_ZERO_BYTES = 1 * MiB;
constexpr size_t WS_MOD = 1 * MiB, WS_TAB = 1 * MiB + 128 * 1024, WS_TILE = 1 * MiB + 192 * 1024;
constexpr size_t WS_TOKSLOT = 1 * MiB + 512 * 1024, TOKSLOT_BYTES = (size_t)XG_ROWS * 4, WS_WTL = WS_TOKSLOT + TOKSLOT_BYTES;
constexpr size_t WS_XCHG = 3 * MiB, WS_EIDX = 5 * MiB, WS_EWT = 5 * MiB + 256 * 1024;
constexpr size_t WS_WIN = 6 * MiB, WS_WPAB = 14 * MiB, WS_WO = 16 * MiB, WS_WSGM = 18 * MiB, WS_RT = 18 * MiB + 512 * 1024, WS_W13 = 20 * MiB, WS_W2 = 84 * MiB;
constexpr size_t WS_H8 = 116 * MiB, WS_H = 364 * MiB;
constexpr size_t WS_Q = 184 * MiB, WS_K = 216 * MiB, WS_V = 226 * MiB, WS_U = 236 * MiB, WS_VG = 268 * MiB, WS_GR = 300 * MiB, WS_GS = 364 * MiB, WS_YCAT = 428 * MiB, WS_END = 492 * MiB;
constexpr size_t WS_V1 = 300 * MiB, WS_X1B = 428 * MiB;
constexpr size_t WS_Y = 184 * MiB, WS_XG = 184 * MiB, WS_HID = 328 * MiB, WS_YSLOT = 184 * MiB;
constexpr int CW_TMO = 0, CW_CODE = 1, CW_BAR = 4096, CW_SEAM = 16384, SEAM_BANK = 128 * 64, CW_CNT = 40960;
constexpr int RING_BYTES = 131072, LDSCTL_OFF = RING_BYTES, MISC_OFF = LDSCTL_OFF + 320, LDS_BYTES = 147456;
constexpr int NWAVES = 8, NTHR = 512;

typedef unsigned short bf16;
typedef unsigned v4u __attribute__((ext_vector_type(4)));
typedef unsigned v2u __attribute__((ext_vector_type(2)));
typedef float f32x4 __attribute__((ext_vector_type(4)));
typedef float f32x2 __attribute__((ext_vector_type(2)));

__device__ __forceinline__ float bflo(unsigned u) { return __builtin_bit_cast(float, u << 16); }
__device__ __forceinline__ float bfhi(unsigned u) { return __builtin_bit_cast(float, u & 0xffff0000u); }
__device__ __forceinline__ float bf2f(bf16 h) { return __builtin_bit_cast(float, (unsigned)h << 16); }
__device__ __forceinline__ unsigned f2bf(float f) { unsigned u = __builtin_bit_cast(unsigned, f); return (u + 0x7fffu + ((u >> 16) & 1u)) >> 16; }
__device__ __forceinline__ unsigned pk2(float lo, float hi) { return f2bf(lo) | (f2bf(hi) << 16); }
__device__ __forceinline__ float fexp2(float v) { return __builtin_amdgcn_exp2f(v); }
__device__ __forceinline__ float frcp(float v) { return __builtin_amdgcn_rcpf(v); }
__device__ __forceinline__ float sigm(float v) { return frcp(1.f + fexp2(-LOG2E * v)); }
__device__ __forceinline__ float silu(float v) { return v * sigm(v); }
__device__ __forceinline__ float gelu_t(float v) { const float z = 0.7978845608028654f * (v + 0.044715f * v * v * v); return v * sigm(2.f * z); }
__device__ __forceinline__ float clamp8(float v) { return fminf(fmaxf(v, -448.f), 448.f); }
__device__ __forceinline__ unsigned pk4_fp8(float a, float b, float c, float d) { int p = __builtin_amdgcn_cvt_pk_fp8_f32(clamp8(a), clamp8(b), 0, false); p = __builtin_amdgcn_cvt_pk_fp8_f32(clamp8(c), clamp8(d), p, true); return (unsigned)p; }
constexpr float W8SCALE = 32.f, W8INV = 1.f / 32.f;
__device__ __forceinline__ float wave_sum(float v) {
#pragma unroll
    for (int o = 1; o < 64; o <<= 1) v += __shfl_xor(v, o);
    return v;
}
__device__ __forceinline__ int permsrc(int L) { return 16 * ((L >> 2) & 1) + 4 * (L >> 3) + (L & 3); }
__device__ __forceinline__ int krow_of(int m) { return m < NTOK ? (m >> 13) * KVB + CTX + (m & (SEQ - 1)) : ((m - NTOK) >> 8) * KVB + ((m - NTOK) & (CTX - 1)); }

struct Ctx {
    const float* in[26]; float* out; unsigned char* ws;
    int tid, lane, wave, vcu, G;
    LAS unsigned char* lds;
    __device__ __forceinline__ bf16* b16(size_t off) const { return (bf16*)(ws + off); }
    __device__ __forceinline__ float* f32(size_t off) const { return (float*)(ws + off); }
    __device__ __forceinline__ int* i32(size_t off) const { return (int*)(ws + off); }
};

__device__ __forceinline__ void p0_tr_item(const float* W, int ldw, int k0, int srccol0, bf16* WT, int ldt, bool perm, LAS float* scr, int lane) {
#pragma unroll 8
    for (int i = 0; i < 32; ++i) { const int kk = 2 * i + (lane >> 5); scr[kk * 33 + (lane & 31)] = W[(size_t)(k0 + kk) * ldw + srccol0 + (lane & 31)]; }
    LDS_WAIT(); asm volatile("" ::: "memory");
    const int c = lane & 7;
#pragma unroll
    for (int j = 0; j < 4; ++j) { const int n = (lane >> 3) + 8 * j; const int sg = perm ? permsrc(n) : n; const LAS float* s = scr + (8 * c) * 33 + sg;
        v4u o; o.x = pk2(s[0 * 33], s[1 * 33]); o.y = pk2(s[2 * 33], s[3 * 33]); o.z = pk2(s[4 * 33], s[5 * 33]); o.w = pk2(s[6 * 33], s[7 * 33]);
        *(GAS v4u*)(WT + (size_t)n * ldt + 8 * c) = o; }
    LDS_WAIT(); asm volatile("" ::: "memory");
}
__device__ __forceinline__ void p0_tr_item8(const float* W, int ldw, int k0, int srccol0, unsigned char* WT8, int ldt, bool perm, LAS float* scr, int lane) {
#pragma unroll 8
    for (int i = 0; i < 32; ++i) { const int kk = 2 * i + (lane >> 5); scr[kk * 33 + (lane & 31)] = W[(size_t)(k0 + kk) * ldw + srccol0 + (lane & 31)]; }
    LDS_WAIT(); asm volatile("" ::: "memory");
    const int c = lane & 7;
#pragma unroll
    for (int j = 0; j < 4; ++j) { const int n = (lane >> 3) + 8 * j; const int sg = perm ? permsrc(n) : n; const LAS float* s = scr + (8 * c) * 33 + sg;
        v2u o; o.x = pk4_fp8(s[0 * 33] * W8SCALE, s[1 * 33] * W8SCALE, s[2 * 33] * W8SCALE, s[3 * 33] * W8SCALE); o.y = pk4_fp8(s[4 * 33] * W8SCALE, s[5 * 33] * W8SCALE, s[6 * 33] * W8SCALE, s[7 * 33] * W8SCALE);
        *(GAS v2u*)(WT8 + (size_t)n * ldt + 8 * c) = o; }
    LDS_WAIT(); asm volatile("" ::: "memory");
}
__device__ __forceinline__ void p0_prologue(const Ctx& C) {
    const float* c_in = C.in[1]; const float* cctx = C.in[3]; const float* w_ada = C.in[4]; const float* b_ada = C.in[5];
    {
        LAS float* sc = (LAS float*)C.lds;
        LAS float* part = (LAS float*)(C.lds + 32768);
        for (int i = C.tid; i < 5 * D; i += NTHR) { const int r = i >> 10, k = i & 1023; const float v = r < 4 ? c_in[r * D + k] : cctx[k]; sc[i] = silu(v); }
        __syncthreads();
        for (int n0 = C.vcu * 24; n0 < 6 * D; n0 += C.G * 24) {
            const int col = C.tid % 24, ks = C.tid / 24;
            if (ks < 21) {
                float a0 = 0.f, a1 = 0.f, a2 = 0.f, a3 = 0.f, a4 = 0.f;
#pragma unroll 7
                for (int k = ks; k < D; k += 21) { const float w = w_ada[(size_t)k * 6 * D + n0 + col];
                    a0 += sc[k] * w; a1 += sc[D + k] * w; a2 += sc[2 * D + k] * w; a3 += sc[3 * D + k] * w; a4 += sc[4 * D + k] * w; }
                LAS float* p = part + (ks * 5) * 24 + col; p[0] = a0; p[24] = a1; p[48] = a2; p[72] = a3; p[96] = a4;
            }
            __syncthreads();
            if (C.tid < 120) { const int r = C.tid / 24, cc = C.tid % 24; float s = 0.f;
                for (int q = 0; q < 21; ++q) s += part[(q * 5 + r) * 24 + cc];
                C.f32(WS_MOD)[r * 6 * D + n0 + cc] = s + b_ada[n0 + cc]; }
            __syncthreads();
        }
    }
    LAS float* scr = (LAS float*)(C.lds + C.wave * 16384);
    const int gw = C.vcu * NWAVES + C.wave, NGW = C.G * NWAVES;
    constexpr int I_IN = 16 * 120, I_PAB = 512, I_O = 512, I_13 = NEXP * 512, I_2 = NEXP * 256, NITEMS = I_IN + I_PAB + I_O + I_13 + I_2;
    for (int it = gw; it < NITEMS; it += NGW) {
        int r = it;
        if (r < I_IN) { const int kb = r / 120, nb = r % 120, n0 = 32 * nb; int src = n0; bool perm = n0 < 640;
            if (n0 >= 1792) { const int i = (n0 - 1792) >> 8, within = (n0 - 1792) & 255; src = ((within >> 7) ? 2816 : 1792) + 128 * i + (within & 127); }
            p0_tr_item8(C.in[6], INW, 64 * kb, src, C.ws + WS_WIN + (size_t)n0 * D + 64 * kb, D, perm, scr, C.lane); continue; }
        r -= I_IN;
        if (r < I_PAB) { const int which = r >> 8, rr = r & 255, kb = rr >> 5, nb = rr & 31;
            p0_tr_item(which ? C.in[13] : C.in[12], D, 64 * kb, 32 * nb, C.b16(WS_WPAB) + (size_t)(32 * nb) * D + which * 512 + 64 * kb, D, false, scr, C.lane); continue; }
        r -= I_PAB;
        if (r < I_O) { const int kb = r >> 5, nb = r & 31;
            p0_tr_item(C.in[14], D, 64 * kb, 32 * nb, C.b16(WS_WO) + (size_t)(32 * nb) * D + 64 * kb, D, false, scr, C.lane); continue; }
        r -= I_O;
        if (r < I_13) { const int e = r >> 9, rr = r & 511, which = rr >> 8, r2 = rr & 255, kb = r2 >> 4, cb = r2 & 15;
            const int jb = (32 * cb) >> 7, c0 = (32 * cb) & 127, prow = 256 * jb + 128 * which + c0;
            p0_tr_item8((which ? C.in[22] : C.in[21]) + (size_t)e * D * DEXP, DEXP, 64 * kb, 32 * cb, C.ws + WS_W13 + ((size_t)e * 1024 + prow) * D + 64 * kb, D, false, scr, C.lane); continue; }
        r -= I_13;
        { const int e = r >> 8, rr = r & 255, kb = rr >> 5, nb = rr & 31;
            p0_tr_item8(C.in[23] + (size_t)e * DEXP * D, D, 64 * kb, 32 * nb, C.ws + WS_W2 + ((size_t)e * 1024 + 32 * nb) * DEXP + 64 * kb, DEXP, false, scr, C.lane); }
    }
    const int gt = C.vcu * NTHR + C.tid, NGT = C.G * NTHR;
    for (int i = gt; i < XG_ROWS; i += NGT) C.i32(WS_TOKSLOT)[i] = -1;
    for (int i = gt; i < 8 * 128 * 128; i += NGT) {
        const int kp = i & 127, s = kp >> 4, h = (kp >> 3) & 1, j = kp & 7, q = 16 * s + 8 * (j >> 2) + 4 * h + (j & 3);
        C.b16(WS_WSGM)[i] = (bf16)f2bf(C.in[10][(i & ~127) + q]); }
    for (int i = gt; i < 48 * D; i += NGT) {
        const int e = i >> 10, k = i & 1023; float v = 0.f;
        if (e < 4) v = C.in[17][k * 4 + e]; else if (e < 36) { const int g = (e - 4) >> 3, ee = (e - 4) & 7; v = C.in[19][((size_t)g * D + k) * 8 + ee]; }
        C.b16(WS_RT)[i] = (bf16)f2bf(v); }
    for (int i = gt; i < 128 * 16; i += NGT) {
        const int pos = i >> 4, f = i & 15;
        const float inv = exp2f(-(float)f * 0.83048202372184f); const float angf = (float)pos * inv;
        const double twopi = 6.283185307179586476925; double r = (double)angf / twopi; r -= __builtin_rint(r); const double x = r * twopi, x2 = x * x;
        double s = 1.0, cs = 1.0, sterm = 1.0, cterm = 1.0;
        for (int n = 1; n <= 14; ++n) { cterm *= -x2 / (double)((2 * n - 1) * (2 * n)); sterm *= -x2 / (double)((2 * n) * (2 * n + 1)); cs += cterm; s += sterm; }
        C.f32(WS_TAB)[2 * i] = (float)cs; C.f32(WS_TAB)[2 * i + 1] = (float)(s * x); }
}

__device__ __forceinline__ void ln_mod_row8(const float* xrow, const float* sh, const float* sc, unsigned char* orow, int lane) {
    const GAS f32x4* xr = (const GAS f32x4*)xrow + lane;
    f32x4 v[4]; float s = 0.f;
#pragma unroll
    for (int j = 0; j < 4; ++j) { v[j] = xr[64 * j]; s += (v[j].x + v[j].y) + (v[j].z + v[j].w); }
    const float mean = wave_sum(s) * (1.f / D); float s2 = 0.f;
#pragma unroll
    for (int j = 0; j < 4; ++j) { v[j] = v[j] - mean; s2 += (v[j].x * v[j].x + v[j].y * v[j].y) + (v[j].z * v[j].z + v[j].w * v[j].w); }
    const float rstd = 1.f / sqrtf(wave_sum(s2) * (1.f / D) + LN_EPS);
    GAS unsigned* o4 = (GAS unsigned*)orow + lane;
#pragma unroll
    for (int j = 0; j < 4; ++j) { const f32x4 a = *((const GAS f32x4*)sc + lane + 64 * j), b = *((const GAS f32x4*)sh + lane + 64 * j);
        const f32x4 o = v[j] * rstd * (a + 1.f) + b; o4[64 * j] = pk4_fp8(o.x, o.y, o.z, o.w); }
}
__device__ __forceinline__ void p1_ln(const Ctx& C) {
    const int gw = C.vcu * NWAVES + C.wave, NGW = C.G * NWAVES; const float* mod = C.f32(WS_MOD);
    for (int m = gw; m < HROWS; m += NGW) {
        const float* src = m < NTOK ? C.in[0] + (size_t)m * D : C.in[2] + (size_t)(m - NTOK) * D;
        const float* md = mod + (m < NTOK ? (m >> 13) : 4) * 6 * D;
        ln_mod_row8(src, md, md + D, C.ws + WS_H8 + (size_t)m * D, C.lane);
    }
}

__device__ __forceinline__ void p7_gather(const Ctx& C) {
    const int* cnt = (const int*)(C.ws + WS_CTL) + CW_CNT;
    LAS int* part = (LAS int*)C.lds;
    LAS int* tot = part + 512;
    LAS int* base = tot + 32;
    LAS int* off = base + 32;
    LAS int* le = off + 32;
    LAS int* lpos = le + 256;
    { const int e = C.tid & 31, pt = C.tid >> 5; int s = 0; for (int q = 0; q < 16; ++q) s += __hip_atomic_load(cnt + (pt * 16 + q) * 32 + e, __ATOMIC_RELAXED, __HIP_MEMORY_SCOPE_AGENT); part[pt * 32 + e] = s; }
    __syncthreads();
    if (C.tid < 32) { int s = 0; for (int q = 0; q < 16; ++q) s += part[q * 32 + C.tid]; tot[C.tid] = s; }
    __syncthreads();
    if (C.tid == 0) { int b = 0; for (int e = 0; e < 32; ++e) { base[e] = b; b += (tot[e] + 255) & ~255; }
        if (C.vcu == 0) { int* tl = C.i32(WS_TILE); int nt = 0; for (int e = 0; e < 32; ++e) { const int k = (tot[e] + 255) >> 8; for (int q = 0; q < k; ++q) tl[1 + nt + q] = e; nt += k; } tl[0] = nt; } }
    __syncthreads();
    for (int slot = C.vcu; slot < NTOK / 128; slot += C.G) {
        if (C.tid < 32) { int s = base[C.tid]; for (int q = 0; q < slot; ++q) s += __hip_atomic_load(cnt + q * 32 + C.tid, __ATOMIC_RELAXED, __HIP_MEMORY_SCOPE_AGENT); off[C.tid] = s; }
        if (C.tid < 256) le[C.tid] = C.i32(WS_EIDX)[slot * 256 + C.tid];
        __syncthreads();
        if (C.tid < 256) { const int e = le[C.tid]; int r = 0; for (int q = 0; q < C.tid; ++q) r += (le[q] == e) ? 1 : 0; const int pos = off[e] + r; lpos[C.tid] = pos;
            C.i32(WS_TOKSLOT)[pos] = slot * 256 + C.tid; C.f32(WS_WTL)[pos] = C.f32(WS_EWT)[slot * 256 + C.tid]; }
        __syncthreads();
        for (int i0 = C.wave * 32; i0 < C.wave * 32 + 32; i0 += 16) {
            v4u ra[16];
#pragma unroll
            for (int q = 0; q < 16; ++q) { const int i = i0 + q, m = slot * 128 + (i >> 1); ra[q] = ((const GAS v4u*)(C.ws + WS_H8 + (size_t)m * D))[C.lane]; }
#pragma unroll
            for (int q = 0; q < 16; ++q) ((GAS v4u*)(C.ws + WS_XG + (size_t)lpos[i0 + q] * D))[C.lane] = ra[q];
        }
        __syncthreads();
    }
}
__device__ __forceinline__ void p10_final(const Ctx& C) {
    const int gw = C.vcu * NWAVES + C.wave, NGW = C.G * NWAVES; const float* mod = C.f32(WS_MOD); const float* g = C.in[24]; const float* bb = C.in[25];
#pragma unroll 2
    for (int m = gw; m < NTOK; m += NGW) {
        GAS f32x4* xr = (GAS f32x4*)(C.out + (size_t)m * D) + C.lane; const float* g2 = mod + (m >> 13) * 6 * D + 5 * D;
        const GAS v2u* x1 = (const GAS v2u*)(C.b16(WS_X1B) + (size_t)m * D) + C.lane;
        const GAS v2u* y0 = (const GAS v2u*)(C.b16(WS_YSLOT) + (size_t)(2 * m) * D) + C.lane; const GAS v2u* y1 = (const GAS v2u*)(C.b16(WS_YSLOT) + (size_t)(2 * m + 1) * D) + C.lane;
        f32x4 v[4]; float s = 0.f;
#pragma unroll
        for (int j = 0; j < 4; ++j) { const v2u xx = x1[64 * j]; const v2u a = y0[64 * j], b = y1[64 * j]; const f32x4 gg = *((const GAS f32x4*)g2 + C.lane + 64 * j);
            f32x4 y; y.x = bflo(a.x) + bflo(b.x); y.y = bfhi(a.x) + bfhi(b.x); y.z = bflo(a.y) + bflo(b.y); y.w = bfhi(a.y) + bfhi(b.y);
            f32x4 xv; xv.x = bflo(xx.x); xv.y = bfhi(xx.x); xv.z = bflo(xx.y); xv.w = bfhi(xx.y);
            v[j] = xv * ALPHA + gg * y; s += (v[j].x + v[j].y) + (v[j].z + v[j].w); }
        const float mean = wave_sum(s) * (1.f / D); float s2 = 0.f;
#pragma unroll
        for (int j = 0; j < 4; ++j) { v[j] = v[j] - mean; s2 += (v[j].x * v[j].x + v[j].y * v[j].y) + (v[j].z * v[j].z + v[j].w * v[j].w); }
        const float rstd = 1.f / sqrtf(wave_sum(s2) * (1.f / D) + LN_EPS);
#pragma unroll
        for (int j = 0; j < 4; ++j) { const f32x4 a = *((const GAS f32x4*)g + C.lane + 64 * j), b = *((const GAS f32x4*)bb + C.lane + 64 * j); xr[64 * j] = v[j] * rstd * a + b; }
    }
}

typedef pg8::Unit Unit;
__device__ __forceinline__ v4u pack8(const f32x4 a, const f32x4 b) { v4u w; w.x = pg8::cvt_pk_bf16(a[0], a[1]); w.y = pg8::cvt_pk_bf16(a[2], a[3]); w.z = pg8::cvt_pk_bf16(b[0], b[1]); w.w = pg8::cvt_pk_bf16(b[2], b[3]); return w; }
__device__ __forceinline__ void unpack8(const v4u w, f32x4& a, f32x4& b) { a[0] = bflo(w.x); a[1] = bfhi(w.x); a[2] = bflo(w.y); a[3] = bfhi(w.y); b[0] = bflo(w.z); b[1] = bfhi(w.z); b[2] = bflo(w.w); b[3] = bfhi(w.w); }

struct InProjOrder {
    pg8::StaticOrder so;
    __device__ __forceinline__ void init(int G, int c) { so.init(NTOK, INW, G, c); }
    __device__ __forceinline__ bool next(int i, Unit& u) const {
        if (so.next(i, u)) return true;
        const long L = (long)i * so.G + so.c - so.nwg; if (L < 0 || L >= 4) return false;
        u.pm = NTOK / 256 + (int)L; u.pn = 2; u.pb = 2; return true;
    }
    __device__ __forceinline__ void a_ready(const Unit&) const {}
    __device__ __forceinline__ void done(const Unit&) const {}
};
struct EpiInProj {
    static constexpr bool PERM = true, AFTER_DRAIN = false; static constexpr int MID_T = 0;
    bf16 *Q, *K, *V, *U, *VG, *GR, *GS; const float* tab; float osc;
    __device__ __forceinline__ void operator()(const f32x4 (&acc)[2][2][4][2], const Unit& u, int wr, int wc, int fr, int fq) const {
        const int rowb = u.pm * 256 + wr * 64 + fr, cw = wc * 32 + 8 * fq;
        if (u.pn <= 2) {
            const bool isctx = u.pm >= NTOK / 256;
#pragma unroll
            for (int ai = 0; ai < 2; ++ai)
#pragma unroll
                for (int m = 0; m < 4; ++m) {
                    const int row = rowb + ai * 128 + m * 16, t = row & (SEQ - 1), pos = (wc & 1) ? (t & 63) : (t >> 6);
                    f32x4 t0 = (f32x4){1.f, 0.f, 1.f, 0.f}, t1 = t0;
                    if (!isctx) { const GAS f32x4* tp = (const GAS f32x4*)(tab + 2 * (pos * 16 + 4 * fq)); t0 = tp[0]; t1 = tp[1]; }
                    const f32x4 cs = (f32x4){t0[0], t0[2], t1[0], t1[2]}, sn = (f32x4){t0[1], t0[3], t1[1], t1[3]};
                    const int kr = krow_of(row);
#pragma unroll
                    for (int bj = 0; bj < 2; ++bj) {
                        const f32x4 xa = acc[ai][bj][m][0] * osc, xb = acc[ai][bj][m][1] * osc;
                        if (u.pn == 2 && bj == 1) { *(GAS v4u*)(V + (size_t)kr * 128 + cw) = pack8(xa, xb); }
                        else {
                            f32x4 oa = xa * cs - xb * sn, ob = xb * cs + xa * sn;
                            if (u.pn < 2) { oa = oa * QSCALE; ob = ob * QSCALE; *(GAS v4u*)(Q + (size_t)row * 512 + u.pn * 256 + bj * 128 + cw) = pack8(oa, ob); }
                            else *(GAS v4u*)(K + (size_t)kr * 128 + cw) = pack8(oa, ob);
                        }
                    }
                }
        } else if (u.pn <= 6) {
            bf16* dst = (u.pn < 5 ? U : VG) + ((u.pn - 3) & 1) * 256 + cw;
#pragma unroll
            for (int ai = 0; ai < 2; ++ai)
#pragma unroll
                for (int m = 0; m < 4; ++m) { const int row = rowb + ai * 128 + m * 16;
#pragma unroll
                    for (int bj = 0; bj < 2; ++bj) { f32x4 a = acc[ai][bj][m][0] * osc, b = acc[ai][bj][m][1] * osc;
#pragma unroll
                        for (int j = 0; j < 4; ++j) { a[j] = gelu_t(a[j]); b[j] = gelu_t(b[j]); }
                        *(GAS v4u*)(dst + (size_t)row * 512 + bj * 128) = pack8(a, b); } }
        } else {
            const int col = 128 * (u.pn - 7) + cw;
#pragma unroll
            for (int ai = 0; ai < 2; ++ai)
#pragma unroll
                for (int m = 0; m < 4; ++m) { const int row = rowb + ai * 128 + m * 16; f32x4 r[2], s[2];
#pragma unroll
                    for (int n = 0; n < 2; ++n)
#pragma unroll
                        for (int j = 0; j < 4; ++j) { const float ea = fexp2(-LOG2E * osc * acc[ai][0][m][n][j]), eb = fexp2(-LOG2E * osc * acc[ai][1][m][n][j]); const float sb = frcp(1.f + eb); s[n][j] = sb; r[n][j] = (1.f + eb) * frcp(1.f + ea); }
                    *(GAS v4u*)(GR + (size_t)row * D + col) = pack8(r[0], r[1]); *(GAS v4u*)(GS + (size_t)row * D + col) = pack8(s[0], s[1]); }
        }
    }
};
__device__ __forceinline__ void p2_inproj(const Ctx& C) {
    pg8::Gemm g{(const bf16*)(C.ws + WS_H8), (const bf16*)(C.ws + WS_WIN), HROWS, INW, D};
    InProjOrder S; S.init(C.G, (int)blockIdx.x);
    EpiInProj E{C.b16(WS_Q), C.b16(WS_K), C.b16(WS_V), C.b16(WS_U), C.b16(WS_VG), C.b16(WS_GR), C.b16(WS_GS), C.f32(WS_TAB), W8INV};
    pg8::gemm_phase8<EpiInProj, InProjOrder, true, true>((PG8_LAS unsigned char*)C.lds, g, S, E, C.wave);
}

struct EpiMerge {
    static constexpr bool PERM = true, AFTER_DRAIN = false; static constexpr int MID_T = 8;
    const bf16 *GR, *GS; bf16* Y;
    __device__ __forceinline__ void mid(f32x4 (&acc)[2][2][4][2], const Unit& u, int wr, int wc, int fr, int fq) const {
        int rowb = u.pm * 256 + wr * 64 + fr, col = u.pn * 256 + wc * 32 + 8 * fq;
        asm volatile("" : "+v"(rowb), "+v"(col));
        v4u w[2][4][2];
#pragma unroll
        for (int ai = 0; ai < 2; ++ai)
#pragma unroll
            for (int m = 0; m < 4; ++m)
#pragma unroll
                for (int bj = 0; bj < 2; ++bj) w[ai][m][bj] = *(const GAS v4u*)(GR + (size_t)(rowb + ai * 128 + m * 16) * D + col + bj * 128);
#pragma unroll
        for (int ai = 0; ai < 2; ++ai)
#pragma unroll
            for (int m = 0; m < 4; ++m)
#pragma unroll
                for (int bj = 0; bj < 2; ++bj) { f32x4 a, b; unpack8(w[ai][m][bj], a, b); acc[ai][bj][m][0] *= a; acc[ai][bj][m][1] *= b; }
    }
    __device__ __forceinline__ void operator()(const f32x4 (&acc)[2][2][4][2], const Unit& u, int wr, int wc, int fr, int fq) const {
        const int rowb = u.pm * 256 + wr * 64 + fr, col = u.pn * 256 + wc * 32 + 8 * fq;
#pragma unroll
        for (int ai = 0; ai < 2; ++ai)
#pragma unroll
            for (int m = 0; m < 4; ++m)
#pragma unroll
                for (int bj = 0; bj < 2; ++bj) { const size_t off = (size_t)(rowb + ai * 128 + m * 16) * D + col + bj * 128; const v4u w = *(const GAS v4u*)(GS + off); f32x4 a, b; unpack8(w, a, b);
                    *(GAS v4u*)(Y + off) = pack8(acc[ai][bj][m][0] * a, acc[ai][bj][m][1] * b); if (bj) asm volatile("" ::: "memory"); }
    }
};
__device__ __forceinline__ void p4_merge(const Ctx& C) {
    pg8::Gemm g{C.b16(WS_YCAT), C.b16(WS_WPAB), NTOK, D, D};
    pg8::StaticOrder S; S.init(NTOK, D, C.G, (int)blockIdx.x);
    EpiMerge E{C.b16(WS_GR), C.b16(WS_GS), C.b16(WS_Y)};
    pg8::gemm_phase<EpiMerge, pg8::StaticOrder, true, true>((PG8_LAS unsigned char*)C.lds, g, S, E, C.wave);
}

struct MoeOrder {
    const int* tl; int G, c;
    __device__ __forceinline__ bool next(int i, Unit& u) const {
        const int L = i * G + c, nt = tl[0]; if (L >= nt * 4) return false;
        u.pm = L >> 2; u.pn = L & 3; u.pb = tl[1 + (L >> 2)] * 4 + (L & 3); return true;
    }
    __device__ __forceinline__ void a_ready(const Unit&) const {}
    __device__ __forceinline__ void done(const Unit&) const {}
};
struct EpiGateUp {
    static constexpr bool PERM = true, AFTER_DRAIN = false; static constexpr int MID_T = 0;
    unsigned char* HID;
    __device__ __forceinline__ void operator()(const f32x4 (&acc)[2][2][4][2], const Unit& u, int wr, int wc, int fr, int fq) const {
        const int rowb = u.pm * 256 + wr * 64 + fr, col = u.pn * 128 + wc * 32 + 8 * fq;
#pragma unroll
        for (int ai = 0; ai < 2; ++ai)
#pragma unroll
            for (int m = 0; m < 4; ++m) { f32x4 h[2];
#pragma unroll
                for (int n = 0; n < 2; ++n)
#pragma unroll
                    for (int j = 0; j < 4; ++j) h[n][j] = silu(acc[ai][0][m][n][j] * W8INV) * (acc[ai][1][m][n][j] * W8INV);
                v2u w; w.x = pk4_fp8(h[0][0], h[0][1], h[0][2], h[0][3]); w.y = pk4_fp8(h[1][0], h[1][1], h[1][2], h[1][3]);
                *(GAS v2u*)(HID + (size_t)(rowb + ai * 128 + m * 16) * DEXP + col) = w; }
    }
};
struct EpiDown {
    static constexpr bool PERM = true, AFTER_DRAIN = false; static constexpr int MID_T = 0;
    const int* ts; const float* wt; bf16* YS;
    __device__ __forceinline__ void operator()(const f32x4 (&acc)[2][2][4][2], const Unit& u, int wr, int wc, int fr, int fq) const {
        const int rowb = u.pm * 256 + wr * 64 + fr, col = u.pn * 256 + wc * 32 + 8 * fq;
#pragma unroll
        for (int ai = 0; ai < 2; ++ai)
#pragma unroll
            for (int m = 0; m < 4; ++m) { const int row = rowb + ai * 128 + m * 16; const int slot = ts[row]; const float w = wt[row] * W8INV;
                if (slot >= 0) {
#pragma unroll
                    for (int bj = 0; bj < 2; ++bj) *(GAS v4u*)(YS + (size_t)slot * D + col + bj * 128) = pack8(acc[ai][bj][m][0] * w, acc[ai][bj][m][1] * w); } }
    }
};
__device__ __forceinline__ void p8_gateup(const Ctx& C) {
    pg8::Gemm g{(const bf16*)(C.ws + WS_XG), (const bf16*)(C.ws + WS_W13), XG_ROWS, 1024, D};
    MoeOrder S{C.i32(WS_TILE), C.G, C.vcu};
    EpiGateUp E{C.ws + WS_HID};
    pg8::gemm_phase8<EpiGateUp, MoeOrder, true, true>((PG8_LAS unsigned char*)C.lds, g, S, E, C.wave);
}
__device__ __forceinline__ void p9_down(const Ctx& C) {
    pg8::Gemm g{(const bf16*)(C.ws + WS_HID), (const bf16*)(C.ws + WS_W2), XG_ROWS, 1024, DEXP};
    MoeOrder S{C.i32(WS_TILE), C.G, C.vcu};
    EpiDown E{C.i32(WS_TOKSLOT), C.f32(WS_WTL), C.b16(WS_YSLOT)};
    pg8::gemm_phase8<EpiDown, MoeOrder, true, true>((PG8_LAS unsigned char*)C.lds, g, S, E, C.wave);
}

struct EpiWoPre {
    static constexpr bool PERM = true, AFTER_DRAIN = false; static constexpr int MID_T = 0;
    const float* x; const float* mod; bf16* V1;
    __device__ __forceinline__ void operator()(const f32x4 (&acc)[2][2][4][2], const Unit& u, int wr, int wc, int fr, int fq) const {
        const int rowb = u.pm * 256 + wr * 64 + fr, col = u.pn * 256 + wc * 32 + 8 * fq;
        const float* g1 = mod + ((u.pm * 256) >> 13) * 6 * D + 2 * D + col;
        f32x4 gv[2][2];
#pragma unroll
        for (int bj = 0; bj < 2; ++bj) { gv[bj][0] = *(const GAS f32x4*)(g1 + bj * 128); gv[bj][1] = *(const GAS f32x4*)(g1 + bj * 128 + 4); }
#pragma unroll
        for (int ai = 0; ai < 2; ++ai) {
            f32x4 xs[4][2][2];
#pragma unroll
            for (int m = 0; m < 4; ++m)
#pragma unroll
                for (int bj = 0; bj < 2; ++bj) { const float* xp = x + (size_t)(rowb + ai * 128 + m * 16) * D + col + bj * 128; xs[m][bj][0] = *(const GAS f32x4*)xp; xs[m][bj][1] = *(const GAS f32x4*)(xp + 4); }
#pragma unroll
            for (int m = 0; m < 4; ++m)
#pragma unroll
                for (int bj = 0; bj < 2; ++bj)
                    *(GAS v4u*)(V1 + (size_t)(rowb + ai * 128 + m * 16) * D + col + bj * 128) = pack8(xs[m][bj][0] * ALPHA + gv[bj][0] * acc[ai][bj][m][0], xs[m][bj][1] * ALPHA + gv[bj][1] * acc[ai][bj][m][1]);
            asm volatile("" ::: "memory");
        }
    }
};
__device__ __forceinline__ void p5_wo(const Ctx& C) {
    pg8::Gemm g{C.b16(WS_Y), C.b16(WS_WO), NTOK, D, D};
    pg8::StaticOrder S; S.init(NTOK, D, C.G, (int)blockIdx.x);
    EpiWoPre E{C.in[0], C.f32(WS_MOD), C.b16(WS_V1)};
    pg8::gemm_phase<EpiWoPre, pg8::StaticOrder, true, true>((PG8_LAS unsigned char*)C.lds, g, S, E, C.wave);
}

typedef short bf16x8 __attribute__((ext_vector_type(8)));
typedef short s16x4 __attribute__((ext_vector_type(4)));
typedef float f32x16 __attribute__((ext_vector_type(16)));
__device__ __forceinline__ float sum8(const f32x4 a, const f32x4 b) { return ((a[0] + a[1]) + (a[2] + a[3])) + ((b[0] + b[1]) + (b[2] + b[3])); }
__device__ __forceinline__ float sq8(const f32x4 a, const f32x4 b) { return ((a[0] * a[0] + a[1] * a[1]) + (a[2] * a[2] + a[3] * a[3])) + ((b[0] * b[0] + b[1] * b[1]) + (b[2] * b[2] + b[3] * b[3])); }
__device__ __forceinline__ void p5b_rows(const Ctx& C) {
    const bf16* V1 = C.b16(WS_V1); bf16* X1B = C.b16(WS_X1B); bf16* H = C.b16(WS_H); const bf16* RT = C.b16(WS_RT); const float* bg = C.in[18]; const float* be = C.in[20];
    constexpr int RTP = 2064;
    LAS unsigned char* rtl = C.lds;
    LAS float* lg = (LAS float*)(C.lds + 100352 + C.wave * 3200);
    __syncthreads();
    for (int i = C.tid; i < 48 * 128; i += NTHR) { const int e = i >> 7, c = i & 127; *(LAS v4u*)(rtl + e * RTP + c * 16) = *(const GAS v4u*)(RT + (size_t)e * D + c * 8); }
    LDS_WAIT(); __syncthreads();
    const int gw = C.vcu * NWAVES + C.wave, NGW = C.G * NWAVES, lane = C.lane, fr = lane & 15, fq = lane >> 4;
    for (int t0 = gw * 16; t0 < NTOK; t0 += NGW * 16) {
        const float* md = C.f32(WS_MOD) + (t0 >> 13) * 6 * D;
        f32x4 lg1[2][2], lb1[2][2], sc2[2][2], sh2[2][2];
#pragma unroll
        for (int hf = 0; hf < 2; ++hf)
#pragma unroll
            for (int q = 0; q < 2; ++q) { const int c = 512 * hf + 8 * lane + 4 * q;
                lg1[hf][q] = *(const GAS f32x4*)(C.in[15] + c); lb1[hf][q] = *(const GAS f32x4*)(C.in[16] + c); sc2[hf][q] = *(const GAS f32x4*)(md + 4 * D + c) + 1.f; sh2[hf][q] = *(const GAS f32x4*)(md + 3 * D + c); }
#pragma unroll 2
        for (int r = 0; r < 16; ++r) {
            const size_t ro = (size_t)(t0 + r) * D + 8 * lane;
            const v4u w0 = *(const GAS v4u*)(V1 + ro), w1 = *(const GAS v4u*)(V1 + ro + 512);
            f32x4 a[2][2]; unpack8(w0, a[0][0], a[0][1]); unpack8(w1, a[1][0], a[1][1]);
            const float mean = wave_sum(sum8(a[0][0], a[0][1]) + sum8(a[1][0], a[1][1])) * (1.f / D);
#pragma unroll
            for (int hf = 0; hf < 2; ++hf) { a[hf][0] = a[hf][0] - mean; a[hf][1] = a[hf][1] - mean; }
            const float rstd = 1.f / sqrtf(wave_sum(sq8(a[0][0], a[0][1]) + sq8(a[1][0], a[1][1])) * (1.f / D) + LN_EPS);
#pragma unroll
            for (int hf = 0; hf < 2; ++hf) { a[hf][0] = a[hf][0] * rstd * lg1[hf][0] + lb1[hf][0]; a[hf][1] = a[hf][1] * rstd * lg1[hf][1] + lb1[hf][1]; }
            *(GAS v4u*)(X1B + ro) = pack8(a[0][0], a[0][1]); *(GAS v4u*)(X1B + ro + 512) = pack8(a[1][0], a[1][1]);
            const float mean2 = wave_sum(sum8(a[0][0], a[0][1]) + sum8(a[1][0], a[1][1])) * (1.f / D);
#pragma unroll
            for (int hf = 0; hf < 2; ++hf) { a[hf][0] = a[hf][0] - mean2; a[hf][1] = a[hf][1] - mean2; }
            const float rstd2 = 1.f / sqrtf(wave_sum(sq8(a[0][0], a[0][1]) + sq8(a[1][0], a[1][1])) * (1.f / D) + LN_EPS);
#pragma unroll
            for (int hf = 0; hf < 2; ++hf) { a[hf][0] = a[hf][0] * rstd2 * sc2[hf][0] + sh2[hf][0]; a[hf][1] = a[hf][1] * rstd2 * sc2[hf][1] + sh2[hf][1]; }
            *(GAS v4u*)(H + ro) = pack8(a[0][0], a[0][1]); *(GAS v4u*)(H + ro + 512) = pack8(a[1][0], a[1][1]);
            { GAS unsigned char* h8 = (GAS unsigned char*)(C.ws + WS_H8) + ro; v2u e0, e1; e0.x = pk4_fp8(a[0][0][0], a[0][0][1], a[0][0][2], a[0][0][3]); e0.y = pk4_fp8(a[0][1][0], a[0][1][1], a[0][1][2], a[0][1][3]);
              e1.x = pk4_fp8(a[1][0][0], a[1][0][1], a[1][0][2], a[1][0][3]); e1.y = pk4_fp8(a[1][1][0], a[1][1][1], a[1][1][2], a[1][1][3]); *(GAS v2u*)h8 = e0; *(GAS v2u*)(h8 + 512) = e1; }
        }
        asm volatile("s_waitcnt vmcnt(0)" ::: "memory");
        f32x4 a0 = (f32x4){0.f, 0.f, 0.f, 0.f}, a1 = a0, a2 = a0;
        const bf16* hr = H + (size_t)(t0 + fr) * D + 8 * fq; const LAS unsigned char* rr = rtl + fr * RTP + 16 * fq;
        bf16x8 av[32];
#pragma unroll
        for (int s = 0; s < 32; ++s) av[s] = __builtin_nontemporal_load((const GAS bf16x8*)(hr + 32 * s));
#pragma unroll
        for (int s = 0; s < 32; ++s) {
            const bf16x8 b0 = *(const LAS bf16x8*)(rr + 64 * s), b1 = *(const LAS bf16x8*)(rr + 16 * RTP + 64 * s), b2 = *(const LAS bf16x8*)(rr + 32 * RTP + 64 * s);
            a0 = __builtin_amdgcn_mfma_f32_16x16x32_bf16(av[s], b0, a0, 0, 0, 0); a1 = __builtin_amdgcn_mfma_f32_16x16x32_bf16(av[s], b1, a1, 0, 0, 0); a2 = __builtin_amdgcn_mfma_f32_16x16x32_bf16(av[s], b2, a2, 0, 0, 0);
        }
#pragma unroll
        for (int r = 0; r < 4; ++r) { lg[(4 * fq + r) * 49 + fr] = a0[r]; lg[(4 * fq + r) * 49 + 16 + fr] = a1[r]; lg[(4 * fq + r) * 49 + 32 + fr] = a2[r]; }
        LDS_WAIT(); asm volatile("" ::: "memory");
        if (lane < 16) {
            const LAS float* v = lg + lane * 49; const int m = t0 + lane;
            float g4[4];
#pragma unroll
            for (int j = 0; j < 4; ++j) g4[j] = v[j] + bg[j];
            int gi = 0; float gm = g4[0];
#pragma unroll
            for (int j = 1; j < 4; ++j) if (g4[j] > gm) { gm = g4[j]; gi = j; }
            float gs = 0.f;
#pragma unroll
            for (int j = 0; j < 4; ++j) gs += fexp2((g4[j] - gm) * LOG2E);
            const float gwt = 1.f / gs;
            float v8[8];
#pragma unroll
            for (int e = 0; e < 8; ++e) v8[e] = v[4 + gi * 8 + e] + be[gi * 8 + e];
            int i1 = 0; float m1 = v8[0];
#pragma unroll
            for (int e = 1; e < 8; ++e) if (v8[e] > m1) { m1 = v8[e]; i1 = e; }
            int i2 = 0; float m2 = -3.0e38f;
#pragma unroll
            for (int e = 0; e < 8; ++e) if (e != i1 && v8[e] > m2) { m2 = v8[e]; i2 = e; }
            const float e2 = fexp2((m2 - m1) * LOG2E), w1 = 1.f / (1.f + e2), w2 = e2 / (1.f + e2);
            const int ea = gi * 8 + i1, eb = gi * 8 + i2;
            C.i32(WS_EIDX)[2 * m] = ea; C.i32(WS_EIDX)[2 * m + 1] = eb; C.f32(WS_EWT)[2 * m] = gwt * w1; C.f32(WS_EWT)[2 * m + 1] = gwt * w2;
            int* cnt = (int*)(C.ws + WS_CTL) + CW_CNT + (m >> 7) * 32;
            atomicAdd(cnt + ea, 1); atomicAdd(cnt + eb, 1);
        }
        LDS_WAIT(); asm volatile("" ::: "memory");
    }
}

typedef short v4i16_t __attribute__((ext_vector_type(4)));
__device__ __forceinline__ s16x4 vtr(const LAS unsigned char* p) { return __builtin_bit_cast(s16x4, __builtin_amdgcn_ds_read_tr16_b64_v4i16((LAS v4i16_t*)p)); }
__device__ __forceinline__ int crow(int r, int hi) { return (r & 3) + 8 * (r >> 2) + 4 * hi; }
__device__ __forceinline__ float xhalf_max(float v) { auto rr = __builtin_amdgcn_permlane32_swap(__float_as_uint(v), __float_as_uint(v), false, false); return fmaxf(__uint_as_float(rr[0]), __uint_as_float(rr[1])); }
__device__ __forceinline__ float xhalf_sum(float v) { auto rr = __builtin_amdgcn_permlane32_swap(__float_as_uint(v), __float_as_uint(v), false, false); return __uint_as_float(rr[0]) + __uint_as_float(rr[1]); }
#define MK_VFRAG(vp, off) ({ const s16x4 lo_ = vtr((vp) + (off)), hi_ = vtr((vp) + (off) + 512); (bf16x8){lo_[0], lo_[1], lo_[2], lo_[3], hi_[0], hi_[1], hi_[2], hi_[3]}; })

__device__ __forceinline__ void p3_attn(const Ctx& C) {
    const int lane = C.lane, r32 = lane & 31, hi = lane >> 5, w = C.wave;
    LAS unsigned char* Kb = C.lds; LAS unsigned char* Vb = C.lds + 16384;
    const bf16* Q = C.b16(WS_Q); const bf16* Kg = C.b16(WS_K); const bf16* Vg = C.b16(WS_V); bf16* Y = C.b16(WS_YCAT);
    const int upw = (1024 + C.G - 1) / C.G;
    for (int ui = 0; ui < upw; ++ui) {
        const int u = C.vcu * upw + ui; if (u >= 1024) break;
        const int qb = u & 127, hk = (u >> 7) & 1, b = u >> 8, q0 = qb * 64, h = hk * 4 + (w >> 1), qrel = 32 * (w & 1) + r32;
        const size_t qrow = (size_t)b * SEQ + q0 + qrel;
        bf16x8 qr[4];
#pragma unroll
        for (int d0 = 0; d0 < 4; ++d0) qr[d0] = *(const GAS bf16x8*)(Q + qrow * 512 + h * 64 + 16 * d0 + 8 * hi);
        const int jlo = q0 == 0 ? 2 : (q0 == 64 ? 1 : 0), jhi = q0 == SEQ - 64 ? 2 : (q0 == SEQ - 128 ? 3 : 4), nt = 4 + (jhi - jlo + 1);
        float mx = C.in[7][h] * LOG2E, l = hi ? 0.f : 1.f;
        f32x16 o0, o1;
#pragma unroll
        for (int r = 0; r < 16; ++r) { o0[r] = 0.f; o1[r] = 0.f; }
        const int kvrow0 = b * KVB;
#define MK_TROW(ti) ((ti) < 4 ? kvrow0 + 64 * (ti) : kvrow0 + CTX + q0 - 128 + 64 * (jlo + (ti) - 4))
#define MK_STAGE(ti, buf) do { const int row0_ = MK_TROW(ti); \
        __builtin_amdgcn_global_load_lds((const unsigned*)(Kg + (size_t)(row0_ + lane) * 128 + hk * 64 + 8 * w), (LAS unsigned*)(Kb + (buf) * 8192 + w * 1024), 16, 0, 0); \
        __builtin_amdgcn_global_load_lds((const unsigned*)(Vg + (size_t)(row0_ + 16 * (w & 3) + (lane >> 2)) * 128 + hk * 64 + 32 * (w >> 2) + 8 * (lane & 3)), (LAS unsigned*)(Vb + (buf) * 8192 + w * 1024), 16, 0, 0); } while (0)
        MK_STAGE(0, 0);
        for (int ti = 0; ti < nt; ++ti) {
            const int cur = ti & 1;
            __syncthreads();
            if (ti + 1 < nt) MK_STAGE(ti + 1, cur ^ 1);
            const LAS unsigned char* kb = Kb + cur * 8192 + hi * 1024 + r32 * 16;
            f32x16 p0, p1;
#pragma unroll
            for (int r = 0; r < 16; ++r) { p0[r] = 0.f; p1[r] = 0.f; }
#pragma unroll
            for (int d0 = 0; d0 < 4; ++d0) { const bf16x8 k0 = *(const LAS bf16x8*)(kb + d0 * 2048), k1 = *(const LAS bf16x8*)(kb + d0 * 2048 + 512);
                p0 = __builtin_amdgcn_mfma_f32_32x32x16_bf16(k0, qr[d0], p0, 0, 0, 0); p1 = __builtin_amdgcn_mfma_f32_32x32x16_bf16(k1, qr[d0], p1, 0, 0, 0); }
            if (ti >= 4) { const int j = jlo + ti - 4;
                if (j == 0) {
#pragma unroll
                    for (int r = 0; r < 16; ++r) { const int kk = crow(r, hi); if (kk < qrel) p0[r] = -INFINITY; if (kk + 32 < qrel) p1[r] = -INFINITY; } }
                else if (j == 4) {
#pragma unroll
                    for (int r = 0; r < 16; ++r) { const int kk = crow(r, hi); if (kk > qrel) p0[r] = -INFINITY; if (kk + 32 > qrel) p1[r] = -INFINITY; } } }
            float rm = fmaxf(p0[0], p1[0]);
#pragma unroll
            for (int r = 1; r < 16; ++r) rm = fmaxf(rm, fmaxf(p0[r], p1[r]));
            rm = xhalf_max(rm);
            const float mn = fmaxf(mx, rm), f = fexp2(mx - mn); mx = mn;
            float ls = 0.f;
#pragma unroll
            for (int r = 0; r < 16; ++r) { p0[r] = fexp2(p0[r] - mn); p1[r] = fexp2(p1[r] - mn); ls += p0[r] + p1[r]; }
            l = l * f + ls;
#pragma unroll
            for (int r = 0; r < 16; ++r) { o0[r] *= f; o1[r] *= f; }
            v4u pw[4];
#pragma unroll
            for (int q = 0; q < 4; ++q) { pw[0][q] = pg8::cvt_pk_bf16(p0[2 * q], p0[2 * q + 1]); pw[1][q] = pg8::cvt_pk_bf16(p0[8 + 2 * q], p0[9 + 2 * q]); pw[2][q] = pg8::cvt_pk_bf16(p1[2 * q], p1[2 * q + 1]); pw[3][q] = pg8::cvt_pk_bf16(p1[8 + 2 * q], p1[9 + 2 * q]); }
            const LAS unsigned char* vp = Vb + cur * 8192 + ((lane >> 4) & 1) * 32 + (lane & 3) * 8 + (4 * hi + ((lane & 15) >> 2)) * 64;
#pragma unroll
            for (int ks = 0; ks < 4; ++ks) { const bf16x8 pf = __builtin_bit_cast(bf16x8, pw[ks]);
                const bf16x8 v0 = MK_VFRAG(vp, ks * 1024), v1 = MK_VFRAG(vp, 4096 + ks * 1024);
                o0 = __builtin_amdgcn_mfma_f32_32x32x16_bf16(v0, pf, o0, 0, 0, 0); o1 = __builtin_amdgcn_mfma_f32_32x32x16_bf16(v1, pf, o1, 0, 0, 0); }
        }
        l = xhalf_sum(l); const float il = 1.f / l;
        bf16* yr = Y + qrow * D + h * 64 + 4 * hi;
#pragma unroll
        for (int g4 = 0; g4 < 4; ++g4) { v2u a, c2; a.x = pg8::cvt_pk_bf16(o0[4 * g4] * il, o0[4 * g4 + 1] * il); a.y = pg8::cvt_pk_bf16(o0[4 * g4 + 2] * il, o0[4 * g4 + 3] * il);
            c2.x = pg8::cvt_pk_bf16(o1[4 * g4] * il, o1[4 * g4 + 1] * il); c2.y = pg8::cvt_pk_bf16(o1[4 * g4 + 2] * il, o1[4 * g4 + 3] * il);
            *(GAS v2u*)(yr + 8 * g4) = a; *(GAS v2u*)(yr + 32 + 8 * g4) = c2; }
        __syncthreads();
    }
#undef MK_TROW
#undef MK_STAGE
}

__device__ __forceinline__ void p3_gmlp(const Ctx& C) {
    const int lane = C.lane, r32 = lane & 31, hi = lane >> 5, g = C.wave;
    const bf16* VG = C.b16(WS_VG); const bf16* U = C.b16(WS_U); const bf16* WSG = C.b16(WS_WSGM); bf16* Y = C.b16(WS_YCAT);
    LAS f32x2* stats = (LAS f32x2*)(C.lds + LDSCTL_OFF + 1024);
    LAS unsigned char* img = C.lds + g * 16384;
    for (int ck = C.vcu; ck < NTOK / 128; ck += C.G) {
        const size_t row0 = (size_t)ck * 128;
        __syncthreads();
#pragma unroll 4
        for (int i = 0; i < 16; ++i) { const int q = 16 * g + i; const v4u wv = *(const GAS v4u*)(VG + (row0 + q) * 512 + 8 * lane); f32x4 a, b2; unpack8(wv, a, b2);
            const float s = (a[0] + a[1]) + (a[2] + a[3]) + (b2[0] + b2[1]) + (b2[2] + b2[3]); const float mean = wave_sum(s) * (1.f / 512.f);
            a = a - mean; b2 = b2 - mean; const float q2 = (a[0] * a[0] + a[1] * a[1]) + (a[2] * a[2] + a[3] * a[3]) + (b2[0] * b2[0] + b2[1] * b2[1]) + (b2[2] * b2[2] + b2[3] * b2[3]);
            const float rstd = 1.f / sqrtf(wave_sum(q2) * (1.f / 512.f) + LN_EPS);
            if (lane == 0) stats[q] = (f32x2){mean, rstd}; }
        LDS_WAIT(); __syncthreads();
        { const int cc = lane & 7, ch0 = 64 * g + 8 * cc;
            const f32x4 g0 = *(const GAS f32x4*)(C.in[8] + ch0), g1 = *(const GAS f32x4*)(C.in[8] + ch0 + 4), b0 = *(const GAS f32x4*)(C.in[9] + ch0), b1 = *(const GAS f32x4*)(C.in[9] + ch0 + 4);
#pragma unroll 4
            for (int i = 0; i < 16; ++i) { const int q = 8 * i + (lane >> 3); const v4u wv = *(const GAS v4u*)(VG + (row0 + q) * 512 + ch0); f32x4 a, b2; unpack8(wv, a, b2);
                const f32x2 st = stats[q]; a = (a - st.x) * st.y * g0 + b0; b2 = (b2 - st.x) * st.y * g1 + b1;
                *(LAS v4u*)(img + (cc >> 2) * 8192 + (q >> 4) * 1024 + (q & 15) * 64 + (cc & 3) * 16) = pack8(a, b2); } }
        LDS_WAIT(); asm volatile("" ::: "memory");
        f32x16 acc[4][2];
#pragma unroll
        for (int pt = 0; pt < 4; ++pt)
#pragma unroll
            for (int ct = 0; ct < 2; ++ct)
#pragma unroll
                for (int r = 0; r < 16; ++r) acc[pt][ct][r] = 0.f;
        const LAS unsigned char* vp = img + ((lane >> 4) & 1) * 32 + (lane & 3) * 8 + (4 * hi + ((lane & 15) >> 2)) * 64;
        const bf16* wsr = WSG + ((size_t)g * 128 + r32) * 128 + 8 * hi;
#pragma unroll 2
        for (int ks = 0; ks < 8; ++ks) {
            const bf16x8 v0 = MK_VFRAG(vp, ks * 1024), v1 = MK_VFRAG(vp, 8192 + ks * 1024);
#pragma unroll
            for (int pt = 0; pt < 4; ++pt) { const bf16x8 wf = *(const GAS bf16x8*)(wsr + (size_t)pt * 32 * 128 + 16 * ks);
                acc[pt][0] = __builtin_amdgcn_mfma_f32_32x32x16_bf16(v0, wf, acc[pt][0], 0, 0, 0); acc[pt][1] = __builtin_amdgcn_mfma_f32_32x32x16_bf16(v1, wf, acc[pt][1], 0, 0, 0); }
        }
#pragma unroll
        for (int pt = 0; pt < 4; ++pt) { const int p = 32 * pt + r32; const float bsv = C.in[11][g * 128 + p];
            const bf16* ur = U + (row0 + p) * 512 + 64 * g + 4 * hi; bf16* yr = Y + (row0 + p) * D + 512 + 64 * g + 4 * hi;
#pragma unroll
            for (int ct = 0; ct < 2; ++ct)
#pragma unroll
                for (int g4 = 0; g4 < 4; ++g4) { const v2u uv = *(const GAS v2u*)(ur + 32 * ct + 8 * g4);
                    v2u o; o.x = pg8::cvt_pk_bf16(bflo(uv.x) * (acc[pt][ct][4 * g4] + bsv), bfhi(uv.x) * (acc[pt][ct][4 * g4 + 1] + bsv)); o.y = pg8::cvt_pk_bf16(bflo(uv.y) * (acc[pt][ct][4 * g4 + 2] + bsv), bfhi(uv.y) * (acc[pt][ct][4 * g4 + 3] + bsv));
                    *(GAS v2u*)(yr + 32 * ct + 8 * g4) = o; } }
    }
    __syncthreads();
}

#ifndef REP_PHASE
#define REP_PHASE -1
#endif
struct Args { const float* in[26]; float* out; unsigned char* ws; };
__global__ void __launch_bounds__(NTHR, 2) mk_fwd(Args args) {
    extern __shared__ __attribute__((aligned(16))) unsigned char lds_raw[];
    Ctx C;
#pragma unroll
    for (int i = 0; i < 26; ++i) C.in[i] = args.in[i];
    C.out = args.out; C.ws = args.ws;
    C.lds = (LAS unsigned char*)lds_raw;
    C.wave = __builtin_amdgcn_readfirstlane((int)threadIdx.x >> 6); C.lane = (int)__builtin_amdgcn_mbcnt_hi(~0u, __builtin_amdgcn_mbcnt_lo(~0u, 0u)); C.tid = C.wave * 64 + C.lane;
    C.G = gridDim.x; { const int bx = blockIdx.x; C.vcu = (C.G % 8 == 0) ? (bx % 8) * (C.G / 8) + bx / 8 : bx; }
    volatile LAS unsigned* MISC = (volatile LAS unsigned*)(C.lds + MISC_OFF);
    for (int u = C.tid; u < (LDS_BYTES - LDSCTL_OFF) / 4; u += NTHR) ((LAS unsigned*)(C.lds + LDSCTL_OFF))[u] = 0u;
    __syncthreads();
    gu32* ctl = (gu32*)(C.ws + WS_CTL);
    XcdBarrier bar = xcd_barrier_post((unsigned*)(ctl + CW_BAR), MISC + 8, C.tid);
#define GRID_BAR() do { xcd_barrier(bar, C.wave * 64 + (int)__builtin_amdgcn_mbcnt_hi(~0u, __builtin_amdgcn_mbcnt_lo(~0u, 0u))); C.lane = (int)__builtin_amdgcn_mbcnt_hi(~0u, __builtin_amdgcn_mbcnt_lo(~0u, 0u)); asm volatile("" : "+v"(C.lane)); C.tid = C.wave * 64 + C.lane; } while (0)

    p0_prologue(C); GRID_BAR();
#if REP_PHASE == 0
    p0_prologue(C); GRID_BAR();
#endif
    p1_ln(C); GRID_BAR();
#if REP_PHASE == 1
    p1_ln(C); GRID_BAR();
#endif
    p2_inproj(C);
    GRID_BAR();
#if REP_PHASE == 2
    p2_inproj(C); GRID_BAR();
#endif
    p3_attn(C);
#if REP_PHASE == 30
    p3_attn(C);
#endif
    p3_gmlp(C);
#if REP_PHASE == 31
    p3_gmlp(C);
#endif
    GRID_BAR();
    p4_merge(C);
    GRID_BAR();
#if REP_PHASE == 4
    p4_merge(C); GRID_BAR();
#endif
    p5_wo(C);
    GRID_BAR();
    p5b_rows(C);
    GRID_BAR();
    p7_gather(C); GRID_BAR();
#if REP_PHASE == 7
    p7_gather(C); GRID_BAR();
#endif
    p8_gateup(C);
    GRID_BAR();
#if REP_PHASE == 8
    p8_gateup(C); GRID_BAR();
#endif
    p9_down(C);
    GRID_BAR();
#if REP_PHASE == 9
    p9_down(C); GRID_BAR();
#endif
#if REP_PHASE == 100
    GRID_BAR(); GRID_BAR(); GRID_BAR(); GRID_BAR(); GRID_BAR(); GRID_BAR(); GRID_BAR(); GRID_BAR(); GRID_BAR(); GRID_BAR();
#endif
    p10_final(C);
}
}

extern "C" void kernel_launch(void* const* d_in, const int* in_sizes, int n_in, void* d_out, int out_size, void* d_ws, size_t ws_size, hipStream_t stream) {
    using namespace mk;
    static int grid = 0;
    if (grid == 0) {
        if (n_in != 26 || in_sizes[0] != NTOK * D || out_size != NTOK * D || ws_size < WS_END) {
            fprintf(stderr, "kernel_launch: built for 26 inputs, x/out of %d floats, >= %zu bytes of workspace; got n_in %d, in0 %d, out %d, ws %zu; nothing launched\n", NTOK * D, (size_t)WS_END, n_in, n_in > 0 ? in_sizes[0] : -1, out_size, ws_size);
            grid = -1; return; }
        int dev = 0, cus = 0, per_cu = 0;
        if (hipGetDevice(&dev) != hipSuccess || hipDeviceGetAttribute(&cus, hipDeviceAttributeMultiprocessorCount, dev) != hipSuccess) { fprintf(stderr, "kernel_launch: device query failed\n"); grid = -1; return; }
        if (hipFuncSetAttribute((const void*)mk_fwd, hipFuncAttributeMaxDynamicSharedMemorySize, LDS_BYTES) != hipSuccess) { fprintf(stderr, "kernel_launch: hipFuncSetAttribute failed\n"); grid = -1; return; }
        if (hipOccupancyMaxActiveBlocksPerMultiprocessor(&per_cu, (const void*)mk_fwd, NTHR, LDS_BYTES) != hipSuccess || per_cu < 1) fprintf(stderr, "kernel_launch: note: occupancy query reports %d\n", per_cu);
        (void)hipGetLastError();
        grid = cus;
    }
    if (grid < 0) return;
    if (hipMemsetAsync((char*)d_ws + WS_CTL, 0, 256 * 1024, stream) != hipSuccess) { fprintf(stderr, "kernel_launch: memset failed\n"); return; }
    Args a{};
    for (int i = 0; i < 26; ++i) a.in[i] = (const float*)d_in[i];
    a.out = (float*)d_out; a.ws = (unsigned char*)d_ws;
    hipLaunchKernelGGL(mk_fwd, dim3(grid), dim3(NTHR), LDS_BYTES, stream, a);
    const hipError_t le = hipPeekAtLastError();
    if (le != hipSuccess) fprintf(stderr, "kernel_launch: launch failed: %s\n", hipGetErrorName(le));
}
```
